# Optimizing an MI355X kernel written in HIP

```python
import math
import jax, jax.numpy as jnp
from jax import lax
import numpy as np

D_MODEL = 2048
BATCH = 16
SEQ = 256
DEPTH = 4
DEC_BATCH = 8
DEC_SEQ = 4096
PAST_LEN = 256

GRID_W = 64
HY_C = 512
HY_ORDER = 2
SHORT_K = 3
FILT_EMB = 33
FILT_HID = 64
HY_FAST_DECAY = 0.3
HY_SLOW_DECAY = 1.5
HY_TARGET = 1e-2
CM_HEADS = 4
CM_HD = 128
CM_C = CM_HEADS * CM_HD
CHUNK = 128
N_HEADS = 8
N_KV_HEADS = 2
HEAD_DIM = 128
GQA = N_HEADS // N_KV_HEADS
ATT_C = N_HEADS * HEAD_DIM
Q_BLOCK = 128
ROPE_THETA = 10000.0
ROPE_AXIS = HEAD_DIM // 2
D_MIX = HY_C + CM_C + ATT_C
SPLITS = ((HY_ORDER + 1) * HY_C, HY_C, CM_C, CM_C, CM_C, ATT_C, N_KV_HEADS * HEAD_DIM, N_KV_HEADS * HEAD_DIM, ATT_C)
D_IN = sum(SPLITS)
EPS = 1e-6
DN_ALPHA = (2 * DEPTH) ** 0.25
DN_BETA = (8 * DEPTH) ** -0.25

kernel_name = "hymba_hyena_chunkmlp_gqa_dit_step"

F32 = jnp.float32


def _layernorm(x, g, b):
    xf = x.astype(F32)
    mu = jnp.mean(xf, axis=-1, keepdims=True)
    var = jnp.mean(jnp.square(xf - mu), axis=-1, keepdims=True)
    return ((xf - mu) * lax.rsqrt(var + EPS) * g.astype(F32) + b.astype(F32)).astype(x.dtype)


def _rmsnorm(x, g):
    xf = x.astype(F32)
    return (xf * lax.rsqrt(jnp.mean(xf * xf, axis=-1, keepdims=True) + EPS) * g.astype(F32)).astype(x.dtype)


def _short_conv(z, w, b):
    L = z.shape[1]
    pad = SHORT_K // 2
    zp = jnp.pad(z, ((0, 0), (pad, SHORT_K - 1 - pad), (0, 0)))
    out = zp[:, 0:L] * w[0]
    for k in range(1, SHORT_K):
        out = out + zp[:, k:k + L] * w[k]
    return out + b


def _implicit_filters(L, w1, b1, w2, b2, w3, freq):
    pos = jnp.arange(L, dtype=F32)
    t = pos / max(L - 1, 1)
    bands = (FILT_EMB - 1) // 2
    fb = jnp.linspace(1e-4, bands - 1, bands, dtype=F32)
    ang = (2.0 * math.pi / L) * pos[:, None] * fb[None, :]
    feats = jnp.concatenate([t[:, None], jnp.cos(ang), -jnp.sin(ang)], axis=-1)
    fr = freq.astype(F32)
    h = jnp.sin(fr * (feats @ w1.astype(F32) + b1.astype(F32)))
    h = jnp.sin(fr * (h @ w2.astype(F32) + b2.astype(F32)))
    h = (h @ w3.astype(F32)).reshape(L, HY_ORDER, HY_C)
    dist = jnp.abs(pos - (L // 2)) / (L / 2.0)
    deltas = jnp.abs(jnp.linspace(math.log(HY_TARGET) / HY_SLOW_DECAY,
                                  math.log(HY_TARGET) / HY_FAST_DECAY, HY_C, dtype=F32))
    window = jnp.exp(-dist[:, None] * deltas[None, :])
    return h * window[:, None, :]


def _centred_fftconv(z, h, skip):
    L = z.shape[1]
    n = 2 * L
    zf = jnp.fft.rfft(z, n=n, axis=1)
    hf = jnp.fft.rfft(h, n=n, axis=0)
    y = jnp.fft.irfft(zf * hf[None], n=n, axis=1)[:, L // 2:L // 2 + L]
    return y + skip * z


def _hyena(zin, conv_w, conv_b, w1, b1, w2, b2, w3, freq, skip):
    L = zin.shape[1]
    z = _short_conv(zin, conv_w, conv_b).astype(F32)
    h = _implicit_filters(L, w1, b1, w2, b2, w3, freq)
    y = z[..., :HY_C]
    for n in range(HY_ORDER):
        gate_n = z[..., (n + 1) * HY_C:(n + 2) * HY_C]
        y = gate_n * _centred_fftconv(y, h[:, n], skip[n].astype(F32))
    return y.astype(zin.dtype)


def _chunk_mlp(u, v, ln_g, ln_b, w_s, b_s):
    B, L, _ = v.shape
    v = _layernorm(v, ln_g, ln_b)
    vc = v.reshape(B, L // CHUNK, CHUNK, CM_HEADS, CM_HD)
    s = jnp.einsum('hpq,bnqhc->bnphc', w_s, vc) + b_s.T[None, None, :, :, None]
    return u * s.reshape(B, L, CM_C)


def _rope_axis(x, ang):
    F = ang.shape[-1]
    cos = jnp.cos(ang)[None, :, None, :].astype(x.dtype)
    sin = jnp.sin(ang)[None, :, None, :].astype(x.dtype)
    x1, x2 = x[..., :F], x[..., F:]
    return jnp.concatenate([x1 * cos - x2 * sin, x1 * sin + x2 * cos], axis=-1)


def _rope_2d(x, row_ang, col_ang):
    return jnp.concatenate([_rope_axis(x[..., :ROPE_AXIS], row_ang),
                            _rope_axis(x[..., ROPE_AXIS:], col_ang)], axis=-1)


def _block_attention(q, k, v):
    B, L, H, D = q.shape
    nb = L // Q_BLOCK
    qb = q.reshape(B, nb, Q_BLOCK, N_KV_HEADS, GQA, D).transpose(1, 0, 2, 3, 4, 5)
    scale = 1.0 / math.sqrt(D)

    def one_block(qblk):
        s = jnp.einsum('bqkgd,bskd->bkgqs', qblk, k).astype(F32) * scale
        p = jax.nn.softmax(s, axis=-1).astype(v.dtype)
        return jnp.einsum('bkgqs,bskd->bqkgd', p, v)

    o = lax.map(one_block, qb)
    return o.transpose(1, 0, 2, 3, 4, 5).reshape(B, L, H * D)


def _mixer_layer(x, shift, scale, gate, w_in, hy_conv_w, hy_conv_b, hy_f_w1, hy_f_b1, hy_f_w2, hy_f_b2,
                 hy_f_w3, hy_f_freq, hy_skip, cm_ln_g, cm_ln_b, cm_w_s, cm_b_s, q_norm_g, k_norm_g,
                 w_out, ln_g, ln_b, ctx_k, ctx_v, rope):
    B, L, _ = x.shape
    h = x * (1 + scale) + shift
    p = h @ w_in
    idx = np.cumsum(SPLITS)[:-1].tolist()
    hy_z, hy_g, cm_u, cm_v, cm_g, q, k, v, at_g = jnp.split(p, idx, axis=-1)
    y_hy = _hyena(hy_z, hy_conv_w, hy_conv_b, hy_f_w1, hy_f_b1, hy_f_w2, hy_f_b2, hy_f_w3, hy_f_freq,
                  hy_skip) * jax.nn.silu(hy_g)
    y_cm = _chunk_mlp(cm_u, cm_v, cm_ln_g, cm_ln_b, cm_w_s, cm_b_s) * jax.nn.silu(cm_g)
    q = _rmsnorm(q.reshape(B, L, N_HEADS, HEAD_DIM), q_norm_g)
    k = _rmsnorm(k.reshape(B, L, N_KV_HEADS, HEAD_DIM), k_norm_g)
    v = v.reshape(B, L, N_KV_HEADS, HEAD_DIM)
    if ctx_k is None:
        k_all, v_all = k, v
    else:
        row_ang, col_ang = rope
        q = _rope_2d(q, row_ang, col_ang)
        k_all = jnp.concatenate([_rope_2d(k, row_ang, col_ang), ctx_k], axis=1)
        v_all = jnp.concatenate([v, ctx_v], axis=1)
    y_at = _block_attention(q, k_all, v_all) * jax.nn.silu(at_g)
    out = jnp.concatenate([y_hy, y_cm, y_at], axis=-1) @ w_out
    x_new = _layernorm(DN_ALPHA * x + gate * out, ln_g, ln_b)
    return x_new, k, v


def setup_inputs(seed: int = 0) -> dict:
    key = jax.random.key(seed)
    ks = jax.random.split(key, 32)

    def nrm(k, shape, s=1.0):
        return jax.random.normal(k, shape, dtype=F32) * s

    return {
        "x_prompt": nrm(ks[0], (BATCH, SEQ, D_MODEL)),
        "x_sample": nrm(ks[1], (DEC_BATCH, DEC_SEQ, D_MODEL)),
        "cache_k": nrm(ks[2], (DEC_BATCH, DEPTH, PAST_LEN, N_KV_HEADS, HEAD_DIM)),
        "cache_v": nrm(ks[3], (DEC_BATCH, DEPTH, PAST_LEN, N_KV_HEADS, HEAD_DIM)),
        "c": nrm(ks[4], (DEC_BATCH, D_MODEL)),
        "c_ctx": nrm(ks[5], (D_MODEL,)),
        "w_mod": nrm(ks[6], (DEPTH, D_MODEL, 3 * D_MODEL), 0.5 * D_MODEL ** -0.5),
        "b_mod": nrm(ks[7], (DEPTH, 3 * D_MODEL), 0.01),
        "w_in": nrm(ks[8], (DEPTH, D_MODEL, D_IN), D_MODEL ** -0.5),
        "hy_conv_w": nrm(ks[9], (DEPTH, SHORT_K, (HY_ORDER + 1) * HY_C), SHORT_K ** -0.5),
        "hy_conv_b": nrm(ks[10], (DEPTH, (HY_ORDER + 1) * HY_C), 0.01),
        "hy_f_w1": nrm(ks[11], (DEPTH, FILT_EMB, FILT_HID), FILT_EMB ** -0.5),
        "hy_f_b1": nrm(ks[12], (DEPTH, FILT_HID), 0.1),
        "hy_f_w2": nrm(ks[13], (DEPTH, FILT_HID, FILT_HID), FILT_HID ** -0.5),
        "hy_f_b2": nrm(ks[14], (DEPTH, FILT_HID), 0.1),
        "hy_f_w3": nrm(ks[15], (DEPTH, FILT_HID, HY_ORDER * HY_C), 0.1 * FILT_HID ** -0.5),
        "hy_f_freq": 1.0 + nrm(ks[16], (DEPTH, FILT_HID), 0.01),
        "hy_skip": nrm(ks[17], (DEPTH, HY_ORDER, HY_C)),
        "cm_ln_g": 1.0 + nrm(ks[18], (DEPTH, CM_C), 0.01),
        "cm_ln_b": nrm(ks[19], (DEPTH, CM_C), 0.01),
        "cm_w_s": nrm(ks[20], (DEPTH, CM_HEADS, CHUNK, CHUNK), CHUNK ** -0.5),
        "cm_b_s": 1.0 + nrm(ks[21], (DEPTH, CM_HEADS, CHUNK), 0.01),
        "q_norm_g": 1.0 + nrm(ks[22], (DEPTH, HEAD_DIM), 0.01),
        "k_norm_g": 1.0 + nrm(ks[23], (DEPTH, HEAD_DIM), 0.01),
        "w_out": nrm(ks[24], (DEPTH, D_MIX, D_MODEL), DN_BETA * D_MIX ** -0.5),
        "ln_g": 1.0 + nrm(ks[25], (DEPTH, D_MODEL), 0.01),
        "ln_b": nrm(ks[26], (DEPTH, D_MODEL), 0.01),
    }


def reference(x_prompt, x_sample, cache_k, cache_v, c, c_ctx, w_mod, b_mod, w_in, hy_conv_w, hy_conv_b,
              hy_f_w1, hy_f_b1, hy_f_w2, hy_f_b2, hy_f_w3, hy_f_freq, hy_skip, cm_ln_g, cm_ln_b, cm_w_s,
              cm_b_s, q_norm_g, k_norm_g, w_out, ln_g, ln_b):
    L_lat = x_sample.shape[1]
    rows = L_lat // GRID_W
    row = jnp.repeat(jnp.arange(rows, dtype=F32), GRID_W)
    col = jnp.tile(jnp.arange(GRID_W, dtype=F32), rows)
    inv = ROPE_THETA ** (-jnp.arange(0, ROPE_AXIS, 2, dtype=F32) / ROPE_AXIS)
    row_ang = row[:, None] * inv[None, :]
    col_ang = col[:, None] * inv[None, :]

    xp = x_prompt
    xs = x_sample
    new_k = []
    new_v = []
    for l in range(DEPTH):
        lp = (w_in[l], hy_conv_w[l], hy_conv_b[l], hy_f_w1[l], hy_f_b1[l], hy_f_w2[l], hy_f_b2[l],
              hy_f_w3[l], hy_f_freq[l], hy_skip[l], cm_ln_g[l], cm_ln_b[l], cm_w_s[l], cm_b_s[l],
              q_norm_g[l], k_norm_g[l], w_out[l], ln_g[l], ln_b[l])
        m_ctx = jax.nn.silu(c_ctx) @ w_mod[l] + b_mod[l]
        sh, sc, gt = jnp.split(m_ctx, 3, axis=-1)
        xp, k_l, v_l = _mixer_layer(xp, sh, sc, gt, *lp, ctx_k=None, ctx_v=None, rope=None)
        new_k.append(k_l)
        new_v.append(v_l)
        m_lat = (jax.nn.silu(c) @ w_mod[l] + b_mod[l])[:, None, :]
        sh, sc, gt = jnp.split(m_lat, 3, axis=-1)
        xs, _, _ = _mixer_layer(xs, sh, sc, gt, *lp, ctx_k=cache_k[:, l], ctx_v=cache_v[:, l],
                                rope=(row_ang, col_ang))
    new_cache_k = jnp.stack(new_k, axis=1)
    new_cache_v = jnp.stack(new_v, axis=1)
    return (xp, xs, new_cache_k, new_cache_v)
```

```cpp
#include <hip/hip_runtime.h>
#include <hip/hip_cooperative_groups.h>
#include <cstdio>
#include <cstdint>
namespace cg = cooperative_groups;

#ifndef MULTI_LAUNCH
#define MULTI_LAUNCH 0
#endif
#ifndef PMASK
#define PMASK 0xFFF
#endif
#ifndef DUP
#define DUP 0
#endif
#ifndef HYABL
#define HYABL 0
#endif

struct Args {
    const float* in[27]; float* out; unsigned char* ws; int ph_lo, ph_hi;
};
typedef const __attribute__((address_space(4))) Args* KArgsP;
template <class T> __device__ __forceinline__ T* as_global(T* p) { return (T*)(__attribute__((address_space(1))) T*)p; }
__device__ __forceinline__ Args load_args() {
    KArgsP kp = (KArgsP)__builtin_amdgcn_kernarg_segment_ptr();
    asm volatile("" : "+s"(kp));
    Args a;
#pragma unroll
    for (int i = 0; i < 27; ++i) a.in[i] = as_global(kp->in[i]);
    a.out = as_global(kp->out); a.ws = as_global(kp->ws); a.ph_lo = kp->ph_lo; a.ph_hi = kp->ph_hi;
    return a;
}
namespace pg8 {
#define PG8_LAS __attribute__((address_space(3)))
typedef unsigned short bf16_t;
typedef short bf16x8 __attribute__((ext_vector_type(8)));
typedef float f32x4 __attribute__((ext_vector_type(4)));
typedef unsigned u32x4 __attribute__((ext_vector_type(4)));
constexpr int BM = 256, BK = 64, HALF = 128, HTB = HALF * BK * 2, STAGE_BYTES = 8 * HTB, NXCD = 8, WGM = 8;

__host__ __device__ __forceinline__ int lds_byte(int r, int c) { const int st = (r >> 4) * 2 + (c >> 5), rr = r & 15, cc = c & 31, ob = rr * 64 + cc * 2; return st * 1024 + (ob ^ (((ob >> 9) & 1) << 5)); }
__host__ __device__ __forceinline__ void stage_rc(int b, int& R, int& C) { const int st = b / 1024, sb = b % 1024, swz = sb ^ (((sb >> 9) & 1) << 5); R = (st >> 1) * 16 + swz / 64; C = (st & 1) * 32 + (swz % 64) / 2; }
__host__ __device__ __forceinline__ int perm32(int rho) { const int n = rho >> 4, i = rho & 15; return 8 * (i >> 2) + 4 * n + (i & 3); }

struct Unit { int pm, pn; };
struct Gemm { const bf16_t* A; const bf16_t* Bt; int M, N, K; };

struct StaticOrder {
    int nM, nN, nwg, G, c;
    __host__ __device__ void init(int M, int N, int G_, int c_) { nM = M / BM; nN = N / BM; nwg = nM * nN; G = G_; c = c_; }
    __host__ __device__ bool next(int i, Unit& u) const {
        const long L = (long)i * G + c; if (L >= nwg) return false;
        int wgid = (int)L; { const int q = nwg / NXCD, r = nwg % NXCD, xcd = wgid % NXCD, off = wgid / NXCD; wgid = (xcd < r ? xcd * (q + 1) : r * (q + 1) + (xcd - r) * q) + off; }
        const int nig = WGM * nN, gid = wgid / nig, fm = gid * WGM, gsz = (nM - fm) < WGM ? (nM - fm) : WGM;
        u.pm = fm + ((wgid % nig) % gsz); u.pn = (wgid % nig) / gsz; return true;
    }
    __device__ __forceinline__ void a_ready(const Unit&) const {}
    __device__ __forceinline__ void done(const Unit&) const {}
};

__device__ __forceinline__ unsigned cvt_pk_bf16(float lo, float hi) { unsigned r; asm volatile("v_cvt_pk_bf16_f32 %0, %1, %2" : "=v"(r) : "v"(lo), "v"(hi)); return r; }

struct EpiBf16 {
    static constexpr bool PERM = true, AFTER_DRAIN = false;
    bf16_t* O; int ldc;
    __device__ __forceinline__ void operator()(const f32x4 (&acc)[2][2][4][2], const Unit& u, int wr, int wc, int fr, int fq) const {
        const int row0 = u.pm * BM + wr * 64 + fr; const int col0 = u.pn * BM + wc * 32 + 8 * fq;
#pragma unroll
        for (int ai = 0; ai < 2; ++ai)
#pragma unroll
            for (int m = 0; m < 4; ++m) { bf16_t* rowp = O + (size_t)(row0 + ai * HALF + m * 16) * ldc + col0;
#pragma unroll
                for (int bj = 0; bj < 2; ++bj) { const f32x4 v0 = acc[ai][bj][m][0], v1 = acc[ai][bj][m][1];
                    u32x4 w; w.x = cvt_pk_bf16(v0[0], v0[1]); w.y = cvt_pk_bf16(v0[2], v0[3]); w.z = cvt_pk_bf16(v1[0], v1[1]); w.w = cvt_pk_bf16(v1[2], v1[3]);
                    *(u32x4*)(rowp + bj * HALF) = w; } }
    }
};
struct EpiIn {
    static constexpr bool PERM = true, AFTER_DRAIN = false;
    bf16_t* O; bf16_t* ZT; int nrows;
    __device__ __forceinline__ void operator()(const f32x4 (&acc)[2][2][4][2], const Unit& u, int wr, int wc, int fr, int fq) const {
        const int row0 = u.pm * BM + wr * 64 + fr;
        if (u.pn >= 8) {
            const int col0 = (u.pn - 8) * BM + wc * 32 + 8 * fq;
#pragma unroll
            for (int ai = 0; ai < 2; ++ai)
#pragma unroll
                for (int m = 0; m < 4; ++m) { bf16_t* rowp = O + (size_t)(row0 + ai * HALF + m * 16) * 4096 + col0;
#pragma unroll
                    for (int bj = 0; bj < 2; ++bj) { const f32x4 v0 = acc[ai][bj][m][0], v1 = acc[ai][bj][m][1];
                        u32x4 w; w.x = cvt_pk_bf16(v0[0], v0[1]); w.y = cvt_pk_bf16(v0[2], v0[3]); w.z = cvt_pk_bf16(v1[0], v1[1]); w.w = cvt_pk_bf16(v1[2], v1[3]);
                        *(u32x4*)(rowp + bj * HALF) = w; } }
        } else {
            const int col0 = u.pn * BM + wc * 32 + 8 * fq;
            long zo = (long)col0 * nrows + row0;
#pragma unroll
            for (int ai = 0; ai < 2; ++ai)
#pragma unroll
                for (int m = 0; m < 4; ++m) {
#pragma unroll
                    for (int bj = 0; bj < 2; ++bj) { const f32x4 v0 = acc[ai][bj][m][0], v1 = acc[ai][bj][m][1];
                        const unsigned w0 = cvt_pk_bf16(v0[0], v0[1]), w1 = cvt_pk_bf16(v0[2], v0[3]), w2 = cvt_pk_bf16(v1[0], v1[1]), w3 = cvt_pk_bf16(v1[2], v1[3]);
                        bf16_t* zp = ZT + zo + (long)(bj * HALF) * nrows + (ai * HALF + m * 16);
                        zp[0] = (bf16_t)w0; zp[(long)nrows] = (bf16_t)(w0 >> 16); zp[2L * nrows] = (bf16_t)w1; zp[3L * nrows] = (bf16_t)(w1 >> 16);
                        zp[4L * nrows] = (bf16_t)w2; zp[5L * nrows] = (bf16_t)(w2 >> 16); zp[6L * nrows] = (bf16_t)w3; zp[7L * nrows] = (bf16_t)(w3 >> 16); }
                    asm volatile("" : "+v"(zo) :: "memory"); }
        }
    }
};
struct EpiResid {
    static constexpr bool PERM = true, AFTER_DRAIN = false;
    int l; float alpha; int dup;
    __device__ __forceinline__ void operator()(const f32x4 (&acc)[2][2][4][2], const Unit& u, int wr, int wc, int fr, int fq) const {
        const Args a = load_args();
        bf16_t* Ub = (bf16_t*)a.out; float* Xf = (float*)(a.ws + (312u << 20)); const float* xin_p = a.in[0]; const float* xin_s = a.in[1]; const float* stats = (const float*)(a.ws + (936u << 20));
        const int use_ln = l > 0; const bool last = (l == 3); const float* lng = a.in[25] + (use_ln ? (l - 1) * 2048 : 0); const float* lnb = a.in[26] + (use_ln ? (l - 1) * 2048 : 0);
        const float* modl = (const float*)(a.ws + (1u << 20)) + (size_t)l * 9 * 6144;
        const int row0 = u.pm * BM + wr * 64 + fr; const int col0 = u.pn * BM + wc * 32 + 8 * fq;
        const int cond = (u.pm < 16) ? 8 : ((u.pm - 16) >> 4);
        const float* gate = modl + cond * 6144 + 4096 + col0;
        const float* src = (u.pm < 16 ? xin_p : xin_s); const int roff = (u.pm < 16) ? 0 : -4096;
        f32x4 gv[2][2], lg[2][2], lb[2][2];
#pragma unroll
        for (int bj = 0; bj < 2; ++bj)
#pragma unroll
            for (int n = 0; n < 2; ++n) { gv[bj][n] = *(const f32x4*)(gate + bj * HALF + n * 4);
                if (use_ln) { lg[bj][n] = *(const f32x4*)(lng + col0 + bj * HALF + n * 4); lb[bj][n] = *(const f32x4*)(lnb + col0 + bj * HALF + n * 4); }
                else { lg[bj][n] = (f32x4){1.f, 1.f, 1.f, 1.f}; lb[bj][n] = (f32x4){0.f, 0.f, 0.f, 0.f}; } }
#pragma unroll
        for (int ai = 0; ai < 2; ++ai)
#pragma unroll
            for (int m = 0; m < 4; ++m) { const int row = row0 + ai * HALF + m * 16;
                float mu = 0.f, rs = 1.f; if (use_ln) { const float* sp = stats + 2 * (size_t)row; mu = sp[0]; rs = sp[1]; }
                const float* sp2 = src + (size_t)(row + roff) * 2048 + col0; bf16_t* up = Ub + (size_t)row * 2048 + col0; float* xp = Xf + (size_t)row * 2048 + col0;
#pragma unroll
                for (int bj = 0; bj < 2; ++bj) { f32x4 x0, x1;
                    if (use_ln) { const u32x4 w = *(const u32x4*)(up + bj * HALF);
                        x0 = (f32x4){__builtin_bit_cast(float, w.x << 16), __builtin_bit_cast(float, w.x & 0xffff0000u), __builtin_bit_cast(float, w.y << 16), __builtin_bit_cast(float, w.y & 0xffff0000u)};
                        x1 = (f32x4){__builtin_bit_cast(float, w.z << 16), __builtin_bit_cast(float, w.z & 0xffff0000u), __builtin_bit_cast(float, w.w << 16), __builtin_bit_cast(float, w.w & 0xffff0000u)}; }
                    else { x0 = *(const f32x4*)(sp2 + bj * HALF); x1 = *(const f32x4*)(sp2 + bj * HALF + 4); }
                    x0 = (x0 - mu) * rs * lg[bj][0] + lb[bj][0]; x1 = (x1 - mu) * rs * lg[bj][1] + lb[bj][1];
                    x0 = x0 * alpha + gv[bj][0] * acc[ai][bj][m][0]; x1 = x1 * alpha + gv[bj][1] * acc[ai][bj][m][1];
                    if (dup) { *(f32x4*)(xp + bj * HALF) = x0; *(f32x4*)(xp + bj * HALF + 4) = x1; }
                    else { bf16_t* wp = last ? (bf16_t*)Xf + (size_t)row * 2048 + col0 : up; u32x4 o; o.x = cvt_pk_bf16(x0[0], x0[1]); o.y = cvt_pk_bf16(x0[2], x0[3]); o.z = cvt_pk_bf16(x1[0], x1[1]); o.w = cvt_pk_bf16(x1[2], x1[3]); *(u32x4*)(wp + bj * HALF) = o; } } }
    }
};

template <class Epi, class Sched, bool ALIGN_EPI = false, bool SP2 = false>
__device__ __forceinline__ void gemm_phase(PG8_LAS unsigned char* lds, const Gemm g, const Sched& S, const Epi& E, const int tid) {
    const int wid = __builtin_amdgcn_readfirstlane(tid >> 6), lane = tid & 63, wr = wid >> 2, wc = wid & 3, fr = lane & 15, fq = lane >> 4;
    const int K = g.K, nt = K / BK;
    unsigned voffA[2], voffB[2];
#pragma unroll
    for (int i = 0; i < 2; ++i) { int R, C; stage_rc(tid * 16 + i * 8192, R, C); const int Rb = Epi::PERM ? ((R & ~31) + perm32(R & 31)) : R;
        voffA[i] = (unsigned)(R * K + C) * 2u; voffB[i] = (unsigned)(Rb * K + C) * 2u; }
    const size_t kstep = (size_t)(BK * 2);
    const size_t hstep = (size_t)HALF * K * 2;
    const size_t tstep = 2 * hstep;
    const unsigned ldsw = (unsigned)wid * 1024u;
    const int aoff = lds_byte(wr * 64 + fr, fq * 8), boff = lds_byte(wc * 32 + fr, fq * 8);
#define PG8_SA(b, h) (((b) * 2 + (h)) * HTB)
#define PG8_SB(b, h) ((4 + (b) * 2 + (h)) * HTB)
#define PG8_STAGE(bufoff, gbase, voff) do { _Pragma("unroll") for (int _i = 0; _i < 2; ++_i) \
        __builtin_amdgcn_global_load_lds((const unsigned*)((const char*)(gbase) + (voff)[_i]), (PG8_LAS unsigned*)(lds + (bufoff) + ldsw + _i * 8192), 16, 0, 0); } while (0)
#define PG8_LDA(dst, b, h) do { _Pragma("unroll") for (int m = 0; m < 4; ++m) _Pragma("unroll") for (int k = 0; k < 2; ++k) dst[m][k] = *(const PG8_LAS bf16x8*)(lds + PG8_SA(b, h) + aoff + m * 2048 + k * 1024); } while (0)
#define PG8_LDB(dst, b, h) do { _Pragma("unroll") for (int n = 0; n < 2; ++n) _Pragma("unroll") for (int k = 0; k < 2; ++k) dst[n][k] = *(const PG8_LAS bf16x8*)(lds + PG8_SB(b, h) + boff + n * 2048 + k * 1024); } while (0)
#define PG8_MMA(ai, bj, At, Bt) do { __builtin_amdgcn_s_setprio(1); _Pragma("unroll") for (int m = 0; m < 4; ++m) _Pragma("unroll") for (int n = 0; n < 2; ++n) _Pragma("unroll") for (int k = 0; k < 2; ++k) \
        acc[ai][bj][m][n] = __builtin_amdgcn_mfma_f32_16x16x32_bf16(Bt[n][k], At[m][k], acc[ai][bj][m][n], 0, 0, 0); __builtin_amdgcn_s_setprio(0); } while (0)
#define PG8_WAIT_V(n) asm volatile("s_waitcnt vmcnt(" #n ")" ::: "memory")
#define PG8_WAIT_L(n) asm volatile("s_waitcnt lgkmcnt(" #n ")" ::: "memory")
#define PG8_BAR __builtin_amdgcn_s_barrier()
#define PG8_SCHED __builtin_amdgcn_sched_barrier(0)
    Unit cur, nxt; int ui = 0;
    if (!S.next(0, cur)) return;
    f32x4 acc[2][2][4][2];
#pragma unroll
    for (int a = 0; a < 2; ++a)
#pragma unroll
        for (int b = 0; b < 2; ++b)
#pragma unroll
            for (int m = 0; m < 4; ++m)
#pragma unroll
                for (int n = 0; n < 2; ++n) acc[a][b][m][n] = (f32x4){0.f, 0.f, 0.f, 0.f};
    bf16x8 At[4][2], B0[2][2], B1[2][2];
    const char* cA = (const char*)g.A + (size_t)cur.pm * tstep; const char* cB = (const char*)g.Bt + (size_t)cur.pn * tstep;
    S.a_ready(cur);
    if constexpr (SP2) {
        PG8_STAGE(PG8_SB(0, 0), cB, voffB); PG8_STAGE(PG8_SB(0, 1), cB + hstep, voffB); PG8_STAGE(PG8_SA(0, 0), cA, voffA); PG8_STAGE(PG8_SA(0, 1), cA + hstep, voffA);
        if (wr == 1) PG8_BAR;
        PG8_WAIT_V(2); PG8_BAR;
        PG8_STAGE(PG8_SB(1, 0), cB + kstep, voffB); PG8_STAGE(PG8_SA(1, 0), cA + kstep, voffA); PG8_STAGE(PG8_SB(1, 1), cB + hstep + kstep, voffB);
        PG8_WAIT_V(6); PG8_BAR;
    } else {
        PG8_STAGE(PG8_SB(0, 0), cB, voffB); PG8_STAGE(PG8_SA(0, 0), cA, voffA); PG8_STAGE(PG8_SB(0, 1), cB + hstep, voffB); PG8_STAGE(PG8_SA(0, 1), cA + hstep, voffA);
        if (wr == 1) PG8_BAR;
        PG8_WAIT_V(4); PG8_BAR;
        PG8_STAGE(PG8_SB(1, 0), cB + kstep, voffB); PG8_STAGE(PG8_SA(1, 0), cA + kstep, voffA); PG8_STAGE(PG8_SB(1, 1), cB + hstep + kstep, voffB);
        PG8_WAIT_V(6); PG8_BAR;
    }
    for (;;) {
        const bool has_next = S.next(ui + 1, nxt);
        const char* nA = has_next ? (const char*)g.A + (size_t)nxt.pm * tstep : cA; const char* nB = has_next ? (const char*)g.Bt + (size_t)nxt.pn * tstep : cB;
        for (int t = 0; t < nt; t += 2) {
            const bool last = (t == nt - 2);
            const char* a1 = cA + (size_t)(t + 1) * kstep;
            const char* a2 = last ? nA : cA + (size_t)(t + 2) * kstep; const char* b2 = last ? nB : cB + (size_t)(t + 2) * kstep;
            const char* a3 = a2 + kstep; const char* b3 = b2 + kstep;
            if (last && has_next) S.a_ready(nxt);
            if constexpr (SP2) {
            PG8_LDB(B0, 0, 0); PG8_LDB(B1, 0, 1); PG8_SCHED; PG8_LDA(At, 0, 0); PG8_STAGE(PG8_SA(1, 1), a1 + hstep, voffA);
            PG8_WAIT_V(8); PG8_WAIT_L(0); PG8_BAR; PG8_MMA(0, 0, At, B0); PG8_MMA(0, 1, At, B1); PG8_BAR; PG8_SCHED;
            PG8_LDA(At, 0, 1); PG8_STAGE(PG8_SB(0, 0), b2, voffB); PG8_STAGE(PG8_SB(0, 1), b2 + hstep, voffB); PG8_STAGE(PG8_SA(0, 0), a2, voffA);
            PG8_WAIT_V(8); PG8_WAIT_L(0); PG8_BAR; PG8_MMA(1, 0, At, B0); PG8_MMA(1, 1, At, B1); PG8_BAR; PG8_SCHED;
            PG8_LDB(B0, 1, 0); PG8_LDB(B1, 1, 1); PG8_SCHED; PG8_LDA(At, 1, 0); PG8_STAGE(PG8_SA(0, 1), a2 + hstep, voffA);
            PG8_WAIT_V(8); PG8_WAIT_L(0); PG8_BAR; PG8_MMA(0, 0, At, B0); PG8_MMA(0, 1, At, B1); PG8_BAR; PG8_SCHED;
            PG8_LDA(At, 1, 1); PG8_STAGE(PG8_SB(1, 0), b3, voffB); PG8_STAGE(PG8_SB(1, 1), b3 + hstep, voffB); PG8_STAGE(PG8_SA(1, 0), a3, voffA);
            PG8_WAIT_V(8); PG8_WAIT_L(0); PG8_BAR; PG8_MMA(1, 0, At, B0); PG8_MMA(1, 1, At, B1); PG8_BAR; PG8_SCHED;
            } else {
            PG8_LDB(B0, 0, 0); PG8_SCHED; PG8_LDA(At, 0, 0); PG8_STAGE(PG8_SA(1, 1), a1 + hstep, voffA);
            PG8_WAIT_L(8); PG8_BAR; PG8_WAIT_L(0); PG8_MMA(0, 0, At, B0); PG8_BAR; PG8_SCHED;
            PG8_LDB(B1, 0, 1); PG8_STAGE(PG8_SB(0, 0), b2, voffB);
            PG8_BAR; PG8_WAIT_L(0); PG8_MMA(0, 1, At, B1); PG8_BAR;
            PG8_LDA(At, 0, 1); PG8_STAGE(PG8_SA(0, 0), a2, voffA);
            PG8_BAR; PG8_WAIT_L(0); PG8_MMA(1, 0, At, B0); PG8_BAR; PG8_SCHED;
            PG8_STAGE(PG8_SB(0, 1), b2 + hstep, voffB);
            PG8_WAIT_V(6); PG8_BAR; PG8_MMA(1, 1, At, B1); PG8_BAR;
            PG8_LDB(B0, 1, 0); PG8_SCHED; PG8_LDA(At, 1, 0); PG8_STAGE(PG8_SA(0, 1), a2 + hstep, voffA);
            PG8_WAIT_L(8); PG8_BAR; PG8_WAIT_L(0); PG8_MMA(0, 0, At, B0); PG8_BAR; PG8_SCHED;
            PG8_LDB(B1, 1, 1); PG8_STAGE(PG8_SB(1, 0), b3, voffB);
            PG8_BAR; PG8_WAIT_L(0); PG8_MMA(0, 1, At, B1); PG8_BAR;
            PG8_LDA(At, 1, 1); PG8_STAGE(PG8_SA(1, 0), a3, voffA);
            PG8_BAR; PG8_WAIT_L(0); PG8_MMA(1, 0, At, B0); PG8_BAR; PG8_SCHED;
            PG8_STAGE(PG8_SB(1, 1), b3 + hstep, voffB);
            PG8_WAIT_V(6); PG8_BAR; PG8_MMA(1, 1, At, B1); PG8_BAR;
            }
        }
        if constexpr (ALIGN_EPI) { if (wr == 0) PG8_BAR; }
        if constexpr (!Epi::AFTER_DRAIN) { E(acc, cur, wr, wc, fr, fq); S.done(cur); }
        if (!has_next) break;
#pragma unroll
        for (int a = 0; a < 2; ++a)
#pragma unroll
            for (int b = 0; b < 2; ++b)
#pragma unroll
                for (int m = 0; m < 4; ++m)
#pragma unroll
                    for (int n = 0; n < 2; ++n) acc[a][b][m][n] = (f32x4){0.f, 0.f, 0.f, 0.f};
        cur = nxt; cA = nA; cB = nB; ++ui;
        if constexpr (ALIGN_EPI) { if (wr == 1) PG8_BAR; }
    }
    PG8_WAIT_V(0);
    if constexpr (!ALIGN_EPI) { if (wr == 0) PG8_BAR; }
    PG8_BAR;
#undef PG8_SA
#undef PG8_SB
#undef PG8_STAGE
#undef PG8_LDA
#undef PG8_LDB
#undef PG8_MMA
#undef PG8_WAIT_V
#undef PG8_WAIT_L
#undef PG8_BAR
#undef PG8_SCHED
}
}

typedef unsigned short bf16;
typedef short bf16x8 __attribute__((ext_vector_type(8)));
typedef short s16x4 __attribute__((ext_vector_type(4)));
typedef float f32x4 __attribute__((ext_vector_type(4)));
typedef float f32x2 __attribute__((ext_vector_type(2)));
typedef float f32x16 __attribute__((ext_vector_type(16)));
typedef unsigned u32x4 __attribute__((ext_vector_type(4)));
typedef unsigned u32x2 __attribute__((ext_vector_type(2)));

__device__ __forceinline__ unsigned f2bf(float f) { unsigned u = __builtin_bit_cast(unsigned, f); return (u + 0x7fffu + ((u >> 16) & 1u)) >> 16; }
__device__ __forceinline__ unsigned pk2(float lo, float hi) { return pg8::cvt_pk_bf16(lo, hi); }
__device__ __forceinline__ float bflo(unsigned w) { return __builtin_bit_cast(float, w << 16); }
__device__ __forceinline__ float bfhi(unsigned w) { return __builtin_bit_cast(float, w & 0xffff0000u); }
__device__ __forceinline__ float bf2f(bf16 h) { return __builtin_bit_cast(float, (unsigned)h << 16); }
__device__ __forceinline__ float wave_sum(float v) {
#pragma unroll
    for (int o = 1; o < 64; o <<= 1) v += __shfl_xor(v, o);
    return v;
}
__device__ __forceinline__ float silu_f(float v) { return v * __builtin_amdgcn_rcpf(1.f + __builtin_amdgcn_exp2f(-1.4426950408889634f * v)); }
__device__ __forceinline__ float hw_sin(float rad) { float r = rad * 0.15915494309189535f; r = r - floorf(r); return __builtin_amdgcn_sinf(r); }
__device__ __forceinline__ float hw_cos(float rad) { float r = rad * 0.15915494309189535f; r = r - floorf(r); return __builtin_amdgcn_cosf(r); }

constexpr int DM = 2048, DIN = 6144, NL = 4;
constexpr int MP = 4096, MROWS = 36864;
constexpr int LP = 256, LS = 4096, SKV_S = 4352;
constexpr float ALPHA = 1.681792830507429f;
constexpr float LN_EPS = 1e-6f;
constexpr int PST = 4096;
constexpr int C_CMU = 0, C_CMV = 512, C_CMG = 1024, C_Q = 1536, C_K = 2560, C_V = 2816, C_ATG = 3072;
constexpr int FLEN_S = 4096 + 128 + 16, FLEN_P = 256 + 64 + 16;
constexpr size_t MiB = 1u << 20;
constexpr size_t WS_MOD = 1 * MiB;
constexpr size_t WS_FS = 2 * MiB;
constexpr size_t WS_FP = 36 * MiB;
constexpr size_t WS_WIN = 40 * MiB;
constexpr size_t WS_WOUT = 136 * MiB;
constexpr size_t WS_H = 168 * MiB;
constexpr size_t WS_P = 312 * MiB;
constexpr size_t WS_ZT = 600 * MiB;
constexpr size_t WS_MIX = 744 * MiB;
constexpr size_t WS_KL = 888 * MiB, WS_VL = 906 * MiB;
constexpr size_t WS_KP = 924 * MiB, WS_VP = 926 * MiB;
constexpr size_t WS_H2 = 928 * MiB;
constexpr size_t WS_STATS = 936 * MiB; static_assert(WS_STATS == ((size_t)936u << 20) && WS_MOD == ((size_t)1u << 20) && WS_P == ((size_t)312u << 20), "EpiResid hard-codes these two offsets");
constexpr size_t WS_YT = 940 * MiB;
constexpr size_t WS_END = 976 * MiB;
constexpr int LDS_BYTES = 163840;


__device__ __forceinline__ void p0_transpose_item(const float* W, int K, int N, bf16* WT, float* scr, int item, int lane) {
    const int nblk = N / 32, kb = item / nblk, nb = item % nblk, k0 = 64 * kb, n0 = 32 * nb;
#pragma unroll 8
    for (int i = 0; i < 32; ++i) { const int kk = 2 * i + (lane >> 5); scr[kk * 33 + (lane & 31)] = __builtin_nontemporal_load(W + (size_t)(k0 + kk) * N + n0 + (lane & 31)); }
    asm volatile("s_waitcnt lgkmcnt(0)" ::: "memory");
    const int c = lane & 7;
#pragma unroll
    for (int j = 0; j < 4; ++j) { const int n = (lane >> 3) + 8 * j; const float* s = scr + (8 * c) * 33 + n;
        u32x4 o; o.x = pk2(s[0 * 33], s[1 * 33]); o.y = pk2(s[2 * 33], s[3 * 33]); o.z = pk2(s[4 * 33], s[5 * 33]); o.w = pk2(s[6 * 33], s[7 * 33]);
        *(u32x4*)(WT + (size_t)(n0 + n) * K + k0 + 8 * c) = o; }
    asm volatile("s_waitcnt lgkmcnt(0)" ::: "memory");
}

__device__ __forceinline__ void phase0(const Args& a, char* lds, int tid, int lane, int wave, int G) {
    const int gw = blockIdx.x * 8 + wave, NGW = G * 8;
    {
        float* h2buf = (float*)(a.ws + WS_H2);
        for (int task = gw; task < NL * 4352; task += NGW) {
            const int l = task / 4352, tt = task % 4352; const int L = tt < 256 ? 256 : 4096; const int pos = tt < 256 ? tt : tt - 256;
            const float* w1 = a.in[11] + l * 33 * 64; const float* b1 = a.in[12] + l * 64; const float* w2 = a.in[13] + l * 64 * 64; const float* b2 = a.in[14] + l * 64;
            const float fr = a.in[16][l * 64 + lane];
            float pre = b1[lane] + ((float)pos / (float)(L - 1)) * w1[lane];
#pragma unroll
            for (int i = 0; i < 16; ++i) {
                const float fb = 1e-4f + (float)i * ((15.0f - 1e-4f) / 15.0f);
                float rev = ((float)pos * fb) / (float)L; rev = rev - floorf(rev);
                const float cs = __builtin_amdgcn_cosf(rev), sn = __builtin_amdgcn_sinf(rev);
                pre += cs * w1[(1 + i) * 64 + lane] - sn * w1[(17 + i) * 64 + lane];
            }
            const float h1 = hw_sin(fr * pre);
            float pre2 = b2[lane];
#pragma unroll 16
            for (int i = 0; i < 64; ++i) pre2 += __shfl(h1, i) * w2[i * 64 + lane];
            h2buf[(size_t)(l * 4352 + tt) * 64 + lane] = hw_sin(fr * pre2);
        }
    }
    {
        float* scr = (float*)(lds + wave * 8448);
        constexpr int I_IN = 32 * 192, I_OUT = 32 * 64;
        for (int it = gw; it < NL * (I_IN + I_OUT); it += NGW) {
            const int l = it / (I_IN + I_OUT); int r = it % (I_IN + I_OUT);
            if (r < I_IN) p0_transpose_item(a.in[8] + (size_t)l * 2048 * 6144, 2048, 6144, (bf16*)(a.ws + WS_WIN) + (size_t)l * 6144 * 2048, scr, r, lane);
            else p0_transpose_item(a.in[24] + (size_t)l * 2048 * 2048, 2048, 2048, (bf16*)(a.ws + WS_WOUT) + (size_t)l * 2048 * 2048, scr, r - I_IN, lane);
        }
    }
    __syncthreads();
    {
        float* sil = (float*)lds;
        float* red = (float*)(lds + 2048 * 12 * 4);
        for (int idx = tid; idx < 9 * 2048; idx += 512) { const int cond = idx >> 11, k = idx & 2047;
            const float v = cond < 8 ? a.in[4][cond * 2048 + k] : a.in[5][k]; sil[k * 12 + cond] = silu_f(v); }
        __syncthreads();
        float* mod = (float*)(a.ws + WS_MOD);
        for (int item = blockIdx.x; item < NL * 96; item += G) {
            const int l = item / 96, n0 = (item % 96) * 64;
            const float* wm = a.in[6] + (size_t)l * 2048 * 6144 + n0 + lane;
            float acc[9];
#pragma unroll
            for (int c = 0; c < 9; ++c) acc[c] = 0.f;
#pragma unroll 8
            for (int kk = 0; kk < 256; ++kk) { const int k = wave * 256 + kk; const float wv = __builtin_nontemporal_load(wm + (size_t)k * 6144);
                const f32x4 s0 = *(const f32x4*)(sil + k * 12), s1 = *(const f32x4*)(sil + k * 12 + 4); const float s8 = sil[k * 12 + 8];
                acc[0] += s0[0] * wv; acc[1] += s0[1] * wv; acc[2] += s0[2] * wv; acc[3] += s0[3] * wv;
                acc[4] += s1[0] * wv; acc[5] += s1[1] * wv; acc[6] += s1[2] * wv; acc[7] += s1[3] * wv; acc[8] += s8 * wv; }
#pragma unroll
            for (int c = 0; c < 9; ++c) red[(wave * 9 + c) * 64 + lane] = acc[c];
            __syncthreads();
            for (int idx = tid; idx < 576; idx += 512) { const int c = idx >> 6, ln = idx & 63; float s = a.in[7][l * 6144 + n0 + ln];
#pragma unroll
                for (int w = 0; w < 8; ++w) s += red[(w * 9 + c) * 64 + ln];
                mod[(size_t)(l * 9 + c) * 6144 + n0 + ln] = s; }
            __syncthreads();
        }
    }
}

__device__ __forceinline__ void phase_filt2(const Args& a, char* lds, int tid, int G) {
    const float* h2buf = (const float*)(a.ws + WS_H2);
    float* h2s = (float*)lds;
    for (int item = blockIdx.x; item < NL * 2 * 34; item += G) {
        const int l = item / 68, r = item % 68, order = r / 34, ch = r % 34;
        const bool isS = ch < 32; const int L = isS ? 4096 : 256, P = isS ? 64 : 32, FLEN = isS ? FLEN_S : FLEN_P;
        const int t0 = isS ? ch * 128 : (ch - 32) * 128, ttbase = isS ? 256 : 0;
        const int c = tid;
        bf16* R = (bf16*)(a.ws + (isS ? WS_FS : WS_FP)) + (size_t)((l * 2 + order) * 512 + c) * FLEN;
        __syncthreads();
        for (int idx = tid; idx < 128 * 64; idx += 512) h2s[idx] = h2buf[(size_t)(l * 4352 + ttbase + t0) * 64 + idx];
        float w3r[64];
#pragma unroll
        for (int i = 0; i < 64; ++i) w3r[i] = a.in[15][(size_t)(l * 64 + i) * 1024 + order * 512 + c];
        __syncthreads();
        const float la = -4.605170185988091f / 1.5f, lb = -4.605170185988091f / 0.3f;
        const float delta = fabsf(la + (lb - la) * ((float)c / 511.0f));
        const int OFF = L / 2 + P;
        for (int tl = 0; tl < 128; ++tl) {
            const int t = t0 + tl; float s = 0.f;
#pragma unroll
            for (int i = 0; i < 64; i += 4) { const f32x4 hv = *(const f32x4*)(h2s + tl * 64 + i); s += hv[0] * w3r[i] + hv[1] * w3r[i + 1] + hv[2] * w3r[i + 2] + hv[3] * w3r[i + 3]; }
            const float dist = fabsf((float)(t - L / 2)) / (float)(L / 2);
            const float val = s * __expf(-dist * delta);
            R[OFF - (t - L / 2)] = (bf16)f2bf(val);
        }
        if (t0 == 0) { for (int i = 0; i <= P; ++i) R[i] = 0; for (int i = L + P + 1; i < FLEN; ++i) R[i] = 0; }
    }
    __syncthreads();
}

__device__ __forceinline__ void phase_adaln(const Args& a, int l, int lane, int wave, int G) {
    const int gw = blockIdx.x * 8 + wave, NGW = G * 8;
    float* X = a.out; const bf16* Ub = (const bf16*)a.out; const bf16* Ul = (const bf16*)(a.ws + WS_P);
    bf16* H = (bf16*)(a.ws + WS_H); const float* mod = (const float*)(a.ws + WS_MOD); float* stats = (float*)(a.ws + WS_STATS);
    const bool do_ln = l > 0, write_h = l < NL;
    const float* lg = a.in[25] + (do_ln ? (l - 1) * 2048 : 0); const float* lb = a.in[26] + (do_ln ? (l - 1) * 2048 : 0);
    f32x4 g8[8], b8[8];
#pragma unroll
    for (int j = 0; j < 8; ++j) { const int col = 512 * (j >> 1) + 8 * lane + 4 * (j & 1); g8[j] = do_ln ? *(const f32x4*)(lg + col) : (f32x4){1.f, 1.f, 1.f, 1.f}; b8[j] = do_ln ? *(const f32x4*)(lb + col) : (f32x4){0.f, 0.f, 0.f, 0.f}; }
    const int per = (MROWS / 2 + NGW - 1) / NGW, rp0 = gw * per, rp1 = (rp0 + per < MROWS / 2) ? rp0 + per : MROWS / 2;
    f32x4 sh8[8], sc8[8]; int ccur = -1;
#pragma unroll
    for (int j = 0; j < 8; ++j) { sh8[j] = (f32x4){0.f, 0.f, 0.f, 0.f}; sc8[j] = (f32x4){1.f, 1.f, 1.f, 1.f}; }
    for (int rowp = rp0; rowp < rp1; ++rowp) {
        f32x4 v[2][8]; float s[2] = {0.f, 0.f};
#pragma unroll
        for (int rr = 0; rr < 2; ++rr) { const int row = 2 * rowp + rr;
            if (l > 0) { const bf16* ub = ((l < NL) ? Ub : Ul) + (size_t)row * 2048 + 8 * lane;
#pragma unroll
                for (int j = 0; j < 4; ++j) { const u32x4 w = __builtin_nontemporal_load((const u32x4*)(ub + 512 * j));
                    v[rr][2 * j] = (f32x4){bflo(w.x), bfhi(w.x), bflo(w.y), bfhi(w.y)}; v[rr][2 * j + 1] = (f32x4){bflo(w.z), bfhi(w.z), bflo(w.w), bfhi(w.w)}; }
            } else { const float* src = (row < MP ? a.in[0] + (size_t)row * 2048 : a.in[1] + (size_t)(row - MP) * 2048) + 8 * lane;
#pragma unroll
                for (int j = 0; j < 4; ++j) { v[rr][2 * j] = __builtin_nontemporal_load((const f32x4*)(src + 512 * j)); v[rr][2 * j + 1] = __builtin_nontemporal_load((const f32x4*)(src + 512 * j + 4)); } } }
#pragma unroll
        for (int rr = 0; rr < 2; ++rr) { const int row = 2 * rowp + rr;
#pragma unroll
        for (int j = 0; j < 8; ++j) s[rr] += (v[rr][j][0] + v[rr][j][1]) + (v[rr][j][2] + v[rr][j][3]);
        if (do_ln) {
            const float mean = wave_sum(s[rr]) * (1.f / 2048.f); float q = 0.f;
#pragma unroll
            for (int j = 0; j < 8; ++j) { v[rr][j] = v[rr][j] - mean; q += (v[rr][j][0] * v[rr][j][0] + v[rr][j][1] * v[rr][j][1]) + (v[rr][j][2] * v[rr][j][2] + v[rr][j][3] * v[rr][j][3]); }
            const float rstd = 1.f / sqrtf(wave_sum(q) * (1.f / 2048.f) + LN_EPS);
            if (write_h && lane == 0) *(f32x2*)(stats + 2 * (size_t)row) = (f32x2){mean, rstd};
#pragma unroll
            for (int j = 0; j < 8; ++j) v[rr][j] = v[rr][j] * rstd * g8[j] + b8[j];
        }
        if (!write_h) {
#pragma unroll
            for (int j = 0; j < 8; ++j) __builtin_nontemporal_store(v[rr][j], (f32x4*)(X + (size_t)row * 2048 + 512 * (j >> 1) + 8 * lane + 4 * (j & 1)));
        } else {
            const int cond = row < MP ? 8 : ((row - MP) >> 12);
            if (cond != ccur) { ccur = cond; const float* m = mod + (size_t)(l * 9 + cond) * 6144;
#pragma unroll
                for (int j = 0; j < 8; ++j) { const int col = 512 * (j >> 1) + 8 * lane + 4 * (j & 1); sh8[j] = *(const f32x4*)(m + col); sc8[j] = *(const f32x4*)(m + 2048 + col) + 1.f; } }
#pragma unroll
            for (int j = 0; j < 4; ++j) { const int col = 512 * j + 8 * lane;
                const f32x4 h0 = v[rr][2 * j] * sc8[2 * j] + sh8[2 * j], h1 = v[rr][2 * j + 1] * sc8[2 * j + 1] + sh8[2 * j + 1];
                u32x4 w; w.x = pk2(h0[0], h0[1]); w.y = pk2(h0[2], h0[3]); w.z = pk2(h1[0], h1[1]); w.w = pk2(h1[2], h1[3]);
                *(u32x4*)(H + (size_t)row * 2048 + col) = w; }
        }
        }
    }
}

__device__ __forceinline__ void prep_qkv(const Args& a, int l, int lane, int wave, int G) {
    const int gw = blockIdx.x * 8 + wave, NGW = G * 8;
    bf16* P = (bf16*)(a.ws + WS_P);
    bf16* KL = (bf16*)(a.ws + WS_KL); bf16* VL = (bf16*)(a.ws + WS_VL); bf16* KP = (bf16*)(a.ws + WS_KP); bf16* VP = (bf16*)(a.ws + WS_VP);
    float* nck = a.out + (size_t)MROWS * 2048; float* ncv = nck + (size_t)16 * 4 * 256 * 256;
    const int d0 = 8 * (lane & 15), hsub = lane >> 4;
    const f32x4 qg0 = *(const f32x4*)(a.in[22] + l * 128 + d0), qg1 = *(const f32x4*)(a.in[22] + l * 128 + d0 + 4);
    const f32x4 kg0 = *(const f32x4*)(a.in[23] + l * 128 + d0), kg1 = *(const f32x4*)(a.in[23] + l * 128 + d0 + 4);
    const int axis = (lane & 15) >> 3, half = (lane >> 2) & 1, f0 = 8 * (lane & 3);
    float inv[8];
#pragma unroll
    for (int i = 0; i < 8; ++i) inv[i] = exp2f(-(float)(f0 + i) * (13.287712379549449f / 32.f));
    for (int rowp = gw; rowp < MROWS / 2; rowp += NGW) {
        u32x4 rw[2][3], cmv[2];
#pragma unroll
        for (int rr = 0; rr < 2; ++rr) { const bf16* prow = P + (size_t)(2 * rowp + rr) * PST;
            cmv[rr] = *(const u32x4*)(prow + C_CMV + 8 * lane);
#pragma unroll
            for (int j = 0; j < 3; ++j) rw[rr][j] = *(const u32x4*)(prow + C_Q + 512 * j + 8 * lane); }
#pragma unroll
        for (int rr = 0; rr < 2; ++rr) {
        const int row = 2 * rowp + rr;
        {
            const u32x4 w = cmv[rr]; float x[8] = {bflo(w.x), bfhi(w.x), bflo(w.y), bfhi(w.y), bflo(w.z), bfhi(w.z), bflo(w.w), bfhi(w.w)}; float sm = 0.f;
#pragma unroll
            for (int j = 0; j < 8; ++j) sm += x[j];
            const float mean = wave_sum(sm) * (1.f / 512.f); float qq = 0.f;
#pragma unroll
            for (int j = 0; j < 8; ++j) { x[j] -= mean; qq += x[j] * x[j]; }
            const float rstd = 1.f / sqrtf(wave_sum(qq) * (1.f / 512.f) + LN_EPS);
            if (lane == 0) *(f32x2*)((float*)(a.ws + WS_STATS + 512 * 1024) + 2 * (size_t)row) = (f32x2){mean, rstd};
        }
        const bool lat = row >= MP; int b, s; float cs[8], sn[8];
        if (lat) { b = (row - MP) >> 12; s = (row - MP) & 4095; const float pos = (float)(axis ? (s & 63) : (s >> 6));
#pragma unroll
            for (int i = 0; i < 8; ++i) { const float ang = pos * inv[i]; cs[i] = hw_cos(ang); sn[i] = hw_sin(ang); } }
        else { b = row >> 8; s = row & 255;
#pragma unroll
            for (int i = 0; i < 8; ++i) { cs[i] = 1.f; sn[i] = 0.f; } }
        bf16* prow = P + (size_t)row * PST;
#pragma unroll
        for (int j = 0; j < 3; ++j) {
            const int hd = 4 * j + hsub;
            const u32x4 w = rw[rr][j]; float x[8] = {bflo(w.x), bfhi(w.x), bflo(w.y), bfhi(w.y), bflo(w.z), bfhi(w.z), bflo(w.w), bfhi(w.w)};
            float ss = 0.f;
#pragma unroll
            for (int i = 0; i < 8; ++i) ss += x[i] * x[i];
            ss += __shfl_xor(ss, 1); ss += __shfl_xor(ss, 2); ss += __shfl_xor(ss, 4); ss += __shfl_xor(ss, 8);
            const bool normed = hd < 10; const float r = normed ? 1.f / sqrtf(ss * (1.f / 128.f) + LN_EPS) : 1.f;
#pragma unroll
            for (int i = 0; i < 8; ++i) { const float g = !normed ? 1.f : (hd < 8 ? (i < 4 ? qg0[i & 3] : qg1[i & 3]) : (i < 4 ? kg0[i & 3] : kg1[i & 3])); x[i] = x[i] * r * g; }
            float u[8];
#pragma unroll
            for (int i = 0; i < 8; ++i) u[i] = x[i];
#pragma unroll
            for (int i = 0; i < 8; ++i) { const float p = __shfl_xor(x[i], 4);
                const float ro = half == 0 ? (u[i] * cs[i] - p * sn[i]) : (p * sn[i] + u[i] * cs[i]); x[i] = (lat && normed) ? ro : u[i]; }
            u32x4 ow; ow.x = pk2(x[0], x[1]); ow.y = pk2(x[2], x[3]); ow.z = pk2(x[4], x[5]); ow.w = pk2(x[6], x[7]);
            if (j < 2) { *(u32x4*)(prow + C_Q + 512 * j + 8 * lane) = ow; }
            else { const int kv = hsub & 1; const bool isk = hsub < 2;
                if (lat) { bf16* dst = (isk ? KL : VL) + ((size_t)(b * 2 + kv) * SKV_S + s) * 128 + d0; *(u32x4*)dst = ow; }
                else { bf16* dst = (isk ? KP : VP) + ((size_t)(b * 2 + kv) * LP + s) * 128 + d0; *(u32x4*)dst = ow;
                    float* o = (isk ? nck : ncv) + ((size_t)((b * 4 + l) * 256 + s) * 2 + kv) * 128 + d0;
                    *(f32x4*)o = (f32x4){u[0], u[1], u[2], u[3]}; *(f32x4*)(o + 4) = (f32x4){u[4], u[5], u[6], u[7]}; } }
        }
        }
    }
    for (int task = gw; task < 8 * 256 * 2; task += NGW) {
        const int kv = task & 1, j = (task >> 1) & 255, b = task >> 9;
        const size_t so = ((size_t)((b * 4 + l) * 256 + j) * 2 + kv) * 128 + 2 * lane;
        const f32x2 kx = *(const f32x2*)(a.in[2] + so), vx = *(const f32x2*)(a.in[3] + so);
        const size_t d = ((size_t)(b * 2 + kv) * SKV_S + 4096 + j) * 128 + 2 * lane;
        *(unsigned*)(KL + d) = pk2(kx[0], kx[1]); *(unsigned*)(VL + d) = pk2(vx[0], vx[1]);
    }
}

__device__ __forceinline__ void prep_chunkmlp(const Args& a, int l, char* lds, int tid, int lane, int wave, int G) {
    const bf16* P = (const bf16*)(a.ws + WS_P); bf16* MIX = (bf16*)(a.ws + WS_MIX);
    constexpr int VS = 288;
    char* vT = lds;
    const float* lng = a.in[18] + l * 512; const float* lnb = a.in[19] + l * 512;
    const int fr = lane & 15, fq = lane >> 4;
    for (int item = blockIdx.x; item < 288 * 4; item += G) {
        const int ci = item >> 2, hd = item & 3, r0 = ci * 128;
        __syncthreads();
        { const float* st2 = (const float*)(a.ws + WS_STATS + 512 * 1024);
          const int tsub = lane >> 4, chk = lane & 15, ch = 128 * hd + 8 * chk;
          const f32x4 lga = *(const f32x4*)(lng + ch), lgb = *(const f32x4*)(lng + ch + 4), lba = *(const f32x4*)(lnb + ch), lbb = *(const f32x4*)(lnb + ch + 4);
          u32x4 wt[4]; f32x2 sv[4];
#pragma unroll
          for (int i = 0; i < 4; ++i) { const int q = wave * 16 + 4 * i + tsub; wt[i] = *(const u32x4*)(P + (size_t)(r0 + q) * PST + C_CMV + ch); sv[i] = *(const f32x2*)(st2 + 2 * (size_t)(r0 + q)); }
#pragma unroll
          for (int i = 0; i < 4; ++i) { const int q = wave * 16 + 4 * i + tsub; const u32x4 w = wt[i]; const float mean = sv[i][0], rstd = sv[i][1];
              const float x[8] = {bflo(w.x), bfhi(w.x), bflo(w.y), bfhi(w.y), bflo(w.z), bfhi(w.z), bflo(w.w), bfhi(w.w)};
#pragma unroll
              for (int j = 0; j < 8; ++j) { const float gg = j < 4 ? lga[j & 3] : lgb[j & 3], bb = j < 4 ? lba[j & 3] : lbb[j & 3]; const float y = (x[j] - mean) * rstd * gg + bb;
                  *(bf16*)(vT + (8 * chk + j) * VS + q * 2) = (bf16)f2bf(y); } } }
        __syncthreads();
        const float* ws_ = a.in[20] + ((size_t)(l * 4 + hd) * 128 + wave * 16 + fr) * 128 + 8 * fq;
        bf16x8 wf[4];
#pragma unroll
        for (int kb = 0; kb < 4; ++kb) { const f32x4 lo = *(const f32x4*)(ws_ + 32 * kb), hi = *(const f32x4*)(ws_ + 32 * kb + 4);
            u32x4 w; w.x = pk2(lo[0], lo[1]); w.y = pk2(lo[2], lo[3]); w.z = pk2(hi[0], hi[1]); w.w = pk2(hi[2], hi[3]); wf[kb] = __builtin_bit_cast(bf16x8, w); }
        f32x4 acc[8];
#pragma unroll
        for (int ct = 0; ct < 8; ++ct) { acc[ct] = (f32x4){0.f, 0.f, 0.f, 0.f};
#pragma unroll
            for (int kb = 0; kb < 4; ++kb) { const bf16x8 vf = *(const bf16x8*)(vT + (16 * ct + fr) * VS + 64 * kb + 16 * fq);
                acc[ct] = __builtin_amdgcn_mfma_f32_16x16x32_bf16(vf, wf[kb], acc[ct], 0, 0, 0); } }
        const int pl = wave * 16 + fr, row = r0 + pl; const float bs = a.in[21][(l * 4 + hd) * 128 + pl];
        const bf16* prow = P + (size_t)row * PST; bf16* mrow = MIX + (size_t)row * 2048 + 512 + 128 * hd;
#pragma unroll
        for (int ct = 0; ct < 8; ++ct) { const int c4 = 16 * ct + 4 * fq;
            const u32x2 uw = *(const u32x2*)(prow + C_CMU + 128 * hd + c4), gw_ = *(const u32x2*)(prow + C_CMG + 128 * hd + c4);
            const float y0 = bflo(uw.x) * (acc[ct][0] + bs) * silu_f(bflo(gw_.x)), y1 = bfhi(uw.x) * (acc[ct][1] + bs) * silu_f(bfhi(gw_.x));
            const float y2 = bflo(uw.y) * (acc[ct][2] + bs) * silu_f(bflo(gw_.y)), y3 = bfhi(uw.y) * (acc[ct][3] + bs) * silu_f(bfhi(gw_.y));
            u32x2 o; o.x = pk2(y0, y1); o.y = pk2(y2, y3); *(u32x2*)(mrow + c4) = o; }
    }
    __syncthreads();
}

template <int L, int P, int NB, int ABL = 0>
__device__ __forceinline__ void hyena_item(const Args& a, int l, int c, char* lds, int tid, int lane, int wave) {
    constexpr int NT1 = L / P, NT = NB * NT1 / 16, MT = P / 16, KB = P / 32, D1MAX = (L / 2) / P, OFF = L / 2 + P, FLEN = L + 2 * P + 16, SROW = 2 * P + 32;
    constexpr bool FAST = (NB == 1);
    constexpr int ZW = (NB * NT1 + (FAST ? 1 : 0)) * SROW;
    constexpr int FOFF = 8 * ZW;
    constexpr int FB = ((FLEN * 2 + 15) / 16) * 16, CB = 8704;
    constexpr unsigned CPACK = 0x62DB0A62u;
#define HY_COFF(k) ((int)((CPACK >> (4 * (k))) & 15u))
    const bf16* ZT = (const bf16*)(a.ws + WS_ZT); bf16* MIX = (bf16*)(a.ws + WS_MIX);
    const bool isS = (L == 4096);
    const int seq0 = isS ? MP + wave * L : (2 * wave) * L;
    char* zw = lds + wave * ZW;
    const int n16 = lane & 15, q4 = lane >> 4;
    __syncthreads();
    const bf16* Rg = (const bf16*)(a.ws + (isS ? WS_FS : WS_FP));
    if constexpr (!FAST) {
      for (int idx = tid; idx < 2 * (FLEN / 8); idx += 512) { const int o = idx / (FLEN / 8), i = idx % (FLEN / 8);
          *(u32x4*)(lds + FOFF + o * FB + i * 16) = *(const u32x4*)(Rg + (size_t)((l * 2 + o) * 512 + c) * FLEN + i * 8); } }
    const float* cw = a.in[9] + l * 3 * 1536; const float* cb = a.in[10] + l * 1536;
    u32x4 xrA[MT][NT], xrB[MT][NT]; u32x2 grB[MT][NT];
    { const bf16* xg = ZT + (size_t)(512 + c) * MROWS + seq0 + (n16 * P + 4 * q4 - 2);
      const bf16* sg = ZT + (size_t)(1536 + c) * MROWS + seq0 + (n16 * P + 4 * q4);
#pragma unroll
      for (int nt = 0; nt < NT; ++nt)
#pragma unroll
          for (int mt = 0; mt < MT; ++mt) {
              if (!(ABL & 4)) { const unsigned* xa = (const unsigned*)(xg + (16 * nt * P + 16 * mt)); xrA[mt][nt] = (u32x4){xa[0], xa[1], xa[2], xa[3]};
                  const unsigned* xb = (const unsigned*)(xg + (size_t)512 * MROWS + (16 * nt * P + 16 * mt)); xrB[mt][nt] = (u32x4){xb[0], xb[1], xb[2], xb[3]};
                  grB[mt][nt] = *(const u32x2*)(sg + (16 * nt * P + 16 * mt)); }
              else { xrA[mt][nt] = (u32x4){0x3f803f80u, 0x3f803f80u, 0x3f803f80u, 0x3f803f80u}; xrB[mt][nt] = xrA[mt][nt]; grB[mt][nt] = (u32x2){0u, 0u}; } } }
    { const bf16* zr = ZT + (size_t)c * MROWS + seq0; const float w0 = cw[c], w1 = cw[1536 + c], w2 = cw[3072 + c], bb = cb[c];
#pragma unroll
      for (int ci = 0; ci < ((ABL & 16) ? 0 : NB * L / 512); ++ci) { const int ch = lane + 64 * ci; const int t = 8 * ch, tl = t & (L - 1);
          const u32x4 w = __builtin_nontemporal_load((const u32x4*)(zr + t));
          float xp = bf2f(zr[t - 1]), xn = bf2f(zr[t + 8]);
          xp = tl == 0 ? 0.f : xp; xn = (tl + 8 == L) ? 0.f : xn;
          const float x0 = bflo(w.x), x1 = bfhi(w.x), x2 = bflo(w.y), x3 = bfhi(w.y), x4 = bflo(w.z), x5 = bfhi(w.z), x6 = bflo(w.w), x7 = bfhi(w.w);
          u32x4 o;
          o.x = pk2(xp * w0 + x0 * w1 + x1 * w2 + bb, x0 * w0 + x1 * w1 + x2 * w2 + bb); o.y = pk2(x1 * w0 + x2 * w1 + x3 * w2 + bb, x2 * w0 + x3 * w1 + x4 * w2 + bb);
          o.z = pk2(x3 * w0 + x4 * w1 + x5 * w2 + bb, x4 * w0 + x5 * w1 + x6 * w2 + bb); o.w = pk2(x5 * w0 + x6 * w1 + x7 * w2 + bb, x6 * w0 + x7 * w1 + xn * w2 + bb);
          *(u32x4*)(zw + (t / P) * SROW + (t % P) * 2) = o; }
      if (FAST && lane < SROW / 16) { unsigned z0; asm volatile("v_mov_b32 %0, 0" : "=v"(z0)); *(u32x4*)(zw + NT1 * SROW + 16 * lane) = (u32x4){z0, z0, z0, z0}; } }
    u32x2 gtA[MT][NT], gtB[MT][NT];
#define HY_GATECALC(oo, XR, GT) do { const int gc = 512 * ((oo) + 1) + c; const float gw0 = cw[gc], gw1 = cw[1536 + gc], gw2 = cw[3072 + gc], gbb = cb[gc]; \
        _Pragma("unroll") for (int nt = 0; nt < NT; ++nt) _Pragma("unroll") for (int mt = 0; mt < MT; ++mt) { \
            const int tl = ((16 * nt + n16) * P + 16 * mt + 4 * q4) & (L - 1); const u32x4 xw = XR[mt][nt]; \
            const float xp = tl == 0 ? 0.f : bfhi(xw.x), xn = (tl + 4 == L) ? 0.f : bflo(xw.w); \
            const float r0 = bflo(xw.y), r1 = bfhi(xw.y), r2 = bflo(xw.z), r3 = bfhi(xw.z); \
            float g0 = xp * gw0 + r0 * gw1 + r1 * gw2 + gbb, g1 = r0 * gw0 + r1 * gw1 + r2 * gw2 + gbb, g2 = r1 * gw0 + r2 * gw1 + r3 * gw2 + gbb, g3 = r2 * gw0 + r3 * gw1 + xn * gw2 + gbb; \
            if ((oo) == 1 && !(ABL & 4)) { const u32x2 gv = grB[mt][nt]; g0 *= silu_f(bflo(gv.x)); g1 *= silu_f(bfhi(gv.x)); g2 *= silu_f(bflo(gv.y)); g3 *= silu_f(bfhi(gv.y)); } \
            GT[mt][nt].x = pk2(g0, g1); GT[mt][nt].y = pk2(g2, g3); } } while (0)
    HY_GATECALC(0, xrA, gtA); HY_GATECALC(1, xrB, gtB);
#undef HY_GATECALC
    if constexpr (!FAST) __syncthreads();
#pragma unroll 1
    for (int o = 0; o < 2; ++o) {
        f32x4 acc[MT][NT];
#pragma unroll
        for (int mt = 0; mt < MT; ++mt)
#pragma unroll
            for (int nt = 0; nt < NT; ++nt) acc[mt][nt] = (f32x4){0.f, 0.f, 0.f, 0.f};
        u32x2 gt[MT][NT];
#pragma unroll
        for (int mt = 0; mt < MT; ++mt)
#pragma unroll
            for (int nt = 0; nt < NT; ++nt) { gt[mt][nt].x = o ? gtB[mt][nt].x : gtA[mt][nt].x; gt[mt][nt].y = o ? gtB[mt][nt].y : gtA[mt][nt].y; }
        if constexpr (FAST) {
            if (o) __syncthreads();
            { const unsigned* Rd = (const unsigned*)(Rg + (size_t)((l * 2 + o) * 512 + c) * FLEN); constexpr int ND = FLEN / 2;
#pragma unroll
              for (int mi = 0; mi < ((ABL & 8) ? 0 : (ND + 511) / 512); ++mi) { const int m = tid + 512 * mi; unsigned d[5];
                  if (m < ND) {
#pragma unroll
                  for (int i = 0; i < 5; ++i) d[i] = (m + i < ND) ? Rd[m + i] : 0u;
#pragma unroll
                  for (int k = 0; k < 8; ++k) { const unsigned v = (k & 1) ? __builtin_amdgcn_alignbit(d[(k + 1) / 2], d[(k - 1) / 2], 16u) : d[k / 2];
                      *(unsigned*)(lds + FOFF + k * CB + 16 * HY_COFF(k) + 4 * m) = v; } } } }
            __syncthreads();
            const int kk = (OFF - n16) & 7;
            const int abase = FOFF + kk * CB + 16 * HY_COFF(kk) + 2 * (OFF - n16 + 8 * q4 - kk) - 96;
            const int bbase = wave * ZW + n16 * SROW + 16 * q4;
            const int zrow = wave * ZW + NT1 * SROW + 16 * q4;
            static_assert(NT == 4 && NT1 == 64 && D1MAX == 32 && MT == 4 && KB == 2, "r-major loop below is for the latent shape");
#define HY_K(K_) do { bf16x8 a0[4], a1[4]; \
                _Pragma("unroll") for (int mt = 0; mt < 4; ++mt) a0[mt] = *(const bf16x8*)(lds + ar + (2048 * (1 - (K_)) + 32 * (3 - mt))); \
                a1[2] = a0[0]; a1[3] = a0[1]; \
                _Pragma("unroll") for (int mt = 0; mt < 2; ++mt) a1[mt] = *(const bf16x8*)(lds + ar + (2048 * (1 - (K_)) + 64 + 32 * (3 - mt))); \
                __builtin_amdgcn_s_setprio(1); \
                _Pragma("unroll") for (int nt = 0; nt < 4; ++nt) { const int j = nt - (K_); if (j < 0 || j > 4) continue; \
                    _Pragma("unroll") for (int mt = 0; mt < 4; ++mt) acc[mt][nt] = __builtin_amdgcn_mfma_f32_16x16x32_bf16(a0[mt], bt[j][0], acc[mt][nt], 0, 0, 0); \
                    _Pragma("unroll") for (int mt = 0; mt < 4; ++mt) acc[mt][nt] = __builtin_amdgcn_mfma_f32_16x16x32_bf16(a1[mt], bt[j][1], acc[mt][nt], 0, 0, 0); } \
                __builtin_amdgcn_s_setprio(0); } while (0)
#pragma unroll 1
            for (int r = 0; r < ((ABL & 2) ? 1 : 16); ++r) {
                bf16x8 bt[5][2];
#pragma unroll
                for (int j = 0; j < 5; ++j) { const bool ok = (unsigned)(16 * j + n16 - r) < (unsigned)NT1; const int ad = ok ? (bbase - r * SROW) : (zrow - 16 * SROW * j);
                    bt[j][0] = *(const bf16x8*)(lds + ad + (16 * SROW * j)); bt[j][1] = *(const bf16x8*)(lds + ad + (16 * SROW * j + 64)); }
                const int ar = abase - 128 * r - 2048;
                HY_K(-2); HY_K(-1); HY_K(0); HY_K(1);
            }
            {
                bf16x8 bt[5][2];
#pragma unroll
                for (int j = 0; j < 2; ++j) { bt[j][0] = *(const bf16x8*)(lds + bbase + (16 * SROW * j)); bt[j][1] = *(const bf16x8*)(lds + bbase + (16 * SROW * j + 64)); }
                bt[2][0] = bt[0][0]; bt[2][1] = bt[0][1]; bt[3][0] = bt[0][0]; bt[3][1] = bt[0][1]; bt[4][0] = bt[0][0]; bt[4][1] = bt[0][1];
                const int ar = abase - 2048;
                if (!(ABL & 2)) HY_K(2);
            }
#undef HY_K
        } else {
        const char* Rl = lds + FOFF + o * FB;
#pragma unroll 1
        for (int d1 = -D1MAX; d1 <= D1MAX; ++d1) {
#pragma unroll
            for (int kb = 0; kb < KB; ++kb) {
                bf16x8 af[MT], bfr[NT];
#pragma unroll
                for (int mt = 0; mt < MT; ++mt) { const int i0 = OFF - P * d1 - 16 * mt - n16 + 32 * kb + 8 * q4; const unsigned sh = (unsigned)(i0 & 1) * 16u;
                    const unsigned* rp = (const unsigned*)(Rl + (i0 >> 1) * 4);
                    const unsigned d0 = rp[0], dd1 = rp[1], d2 = rp[2], d3 = rp[3], d4 = rp[4];
                    u32x4 w; w.x = __builtin_amdgcn_alignbit(dd1, d0, sh); w.y = __builtin_amdgcn_alignbit(d2, dd1, sh); w.z = __builtin_amdgcn_alignbit(d3, d2, sh); w.w = __builtin_amdgcn_alignbit(d4, d3, sh);
                    af[mt] = __builtin_bit_cast(bf16x8, w); }
#pragma unroll
                for (int nt = 0; nt < NT; ++nt) { const int N = 16 * nt + n16, bl = N / NT1, t1 = N % NT1, s1 = t1 - d1; const bool ok = (unsigned)s1 < (unsigned)NT1;
                    u32x4 w = *(const u32x4*)(zw + (bl * NT1 + (ok ? s1 : 0)) * SROW + 64 * kb + 16 * q4);
                    if (!ok) w = (u32x4){0u, 0u, 0u, 0u};
                    bfr[nt] = __builtin_bit_cast(bf16x8, w); }
#pragma unroll
                for (int nt = 0; nt < NT; ++nt) {
#pragma unroll
                    for (int mt = 0; mt < MT; ++mt) acc[mt][nt] = __builtin_amdgcn_mfma_f32_16x16x32_bf16(af[mt], bfr[nt], acc[mt][nt], 0, 0, 0);
                }
            }
        }
        }
        const float skip = a.in[17][(l * 2 + o) * 512 + c];
        bf16* mp = (bf16*)(a.ws + WS_YT) + (size_t)c * MROWS + seq0;
        long to = n16 * P + 4 * q4;
        int zo = n16 * SROW + 8 * q4;
#pragma unroll
        for (int nt = 0; nt < NT; ++nt) {
#pragma unroll
            for (int mt = 0; mt < MT; ++mt) {
                char* zp = zw + zo + 32 * mt; const long t0 = to + 16 * mt;
                const u32x2 zv = *(const u32x2*)zp; const u32x2 gg = gt[mt][nt];
                const float y0 = bflo(gg.x) * (acc[mt][nt][0] + skip * bflo(zv.x)), y1 = bfhi(gg.x) * (acc[mt][nt][1] + skip * bfhi(zv.x));
                const float y2 = bflo(gg.y) * (acc[mt][nt][2] + skip * bflo(zv.y)), y3 = bfhi(gg.y) * (acc[mt][nt][3] + skip * bfhi(zv.y));
                if (o == 0) { u32x2 w; w.x = pk2(y0, y1); w.y = pk2(y2, y3); *(u32x2*)zp = w; }
                else if (ABL & 1) { if (y0 + y1 + y2 + y3 == 123.456f) mp[0] = 0; }
                else { u32x2 w; w.x = pk2(y0, y1); w.y = pk2(y2, y3); *(u32x2*)(mp + t0) = w; } }
            to += 16 * P; zo += 16 * SROW;
            asm volatile("" : "+v"(to), "+v"(zo)); }
    }
    __syncthreads();
}

namespace attn {
constexpr int D = 128, NW = 8, QBLK = 32, KVBLK = 64;
constexpr float SCALE = 0.088388347648318440f;
constexpr float THR = 8.f;
constexpr int LDQ = 4096, LDK = 128;
constexpr size_t SHM_V = KVBLK * D * 2, SHM_K = KVBLK * D * 2;
#define KSWZ(row, colB) ((row) * 256 + ((colB) ^ (((row) & 7) << 4)))
#define SBAR() __builtin_amdgcn_sched_barrier(0)
__device__ __forceinline__ int crow(int r, int hi) { return (r & 3) + 8 * (r >> 2) + 4 * hi; }
__device__ __forceinline__ unsigned cvtpk(float lo, float hi) { unsigned r; asm volatile("v_cvt_pk_bf16_f32 %0, %1, %2" : "=v"(r) : "v"(lo), "v"(hi)); return r; }
__device__ __forceinline__ void partialSM(f32x16& p0, f32x16& p1, float& m_reg, float& mn, float& alpha) {
  constexpr float C = SCALE * 1.4426950408889634f;
  float pmax = p0[0]; for (int r = 1; r < 16; ++r) pmax = fmaxf(pmax, p0[r]); for (int r = 0; r < 16; ++r) pmax = fmaxf(pmax, p1[r]);
  { auto rr = __builtin_amdgcn_permlane32_swap(__float_as_uint(pmax), __float_as_uint(pmax), false, false);
    pmax = fmaxf(__uint_as_float(rr[0]), __uint_as_float(rr[1])); }
  if (__builtin_expect(__all(pmax - m_reg <= THR / SCALE), 1)) { mn = m_reg; alpha = 1.f; }
  else { mn = fmaxf(m_reg, pmax); alpha = __builtin_amdgcn_exp2f((m_reg - mn) * C); m_reg = mn; }
  float mnC = -mn * C;
  for (int r = 0; r < 16; ++r) p0[r] = fmaf(p0[r], C, mnC); for (int r = 0; r < 16; ++r) p1[r] = fmaf(p1[r], C, mnC);
  for (int r = 0; r < 16; ++r) p0[r] = __builtin_amdgcn_exp2f(p0[r]);
}
__device__ __forceinline__ void finishSM(f32x16& p0, f32x16& p1, float alpha, float& l_reg, bf16x8& pa0, bf16x8& pa1, bf16x8& pa2, bf16x8& pa3) {
  for (int r = 0; r < 16; ++r) p1[r] = __builtin_amdgcn_exp2f(p1[r]);
  float ps = 0; for (int r = 0; r < 16; ++r) ps += p0[r]; for (int r = 0; r < 16; ++r) ps += p1[r];
  { auto rr = __builtin_amdgcn_permlane32_swap(__float_as_uint(ps), __float_as_uint(ps), false, false);
    ps = __uint_as_float(rr[0]) + __uint_as_float(rr[1]); }
  l_reg = l_reg * alpha + ps;
#define PK4(Pv, BASE, OUT) do { unsigned a0 = cvtpk(Pv[BASE + 0], Pv[BASE + 1]), a1 = cvtpk(Pv[BASE + 2], Pv[BASE + 3]);   \
    unsigned b0 = cvtpk(Pv[BASE + 4], Pv[BASE + 5]), b1 = cvtpk(Pv[BASE + 6], Pv[BASE + 7]);                              \
    auto r0 = __builtin_amdgcn_permlane32_swap(a0, b0, false, false); auto r1 = __builtin_amdgcn_permlane32_swap(a1, b1, false, false); \
    u32x4 w = {r0[0], r1[0], r0[1], r1[1]}; OUT = *reinterpret_cast<bf16x8*>(&w); } while (0)
  PK4(p0, 0, pa0); PK4(p0, 8, pa1); PK4(p1, 0, pa2); PK4(p1, 8, pa3);
#undef PK4
}
__device__ __forceinline__ void qkt(f32x16& p0, f32x16& p1, const bf16* Ks, const bf16x8* qr, int r32, int hi) {
  p0 = f32x16{}; p1 = f32x16{};
  for (int d0 = 0; d0 < 8; ++d0) { int cb = (d0 * 16 + hi * 8) * 2;
    bf16x8 b0 = *reinterpret_cast<const bf16x8*>((const char*)Ks + KSWZ(r32, cb));
    bf16x8 b1 = *reinterpret_cast<const bf16x8*>((const char*)Ks + KSWZ(32 + r32, cb));
    p0 = __builtin_amdgcn_mfma_f32_32x32x16_bf16(b0, qr[d0], p0, 0, 0, 0);
    p1 = __builtin_amdgcn_mfma_f32_32x32x16_bf16(b1, qr[d0], p1, 0, 0, 0); }
}
__device__ __forceinline__ int v_st(int k, int c) { const int kk = (k & ~0xC) | ((k & 4) << 1) | ((k & 8) >> 1); return ((kk >> 3) * 4 + (c >> 5)) * 512 + ((kk & 7) * 32 + (c & 31)) * 2; }
__device__ __forceinline__ int v_rd_base(int lane) { return ((lane & 3) << 3) | (((lane >> 2) & 3) << 6) | (((lane >> 4) & 1) << 5) | (((lane >> 5) & 1) << 8); }
constexpr int v_rd_off(int d0, int ks, int half) { return d0 * 512 + ks * 4096 + half * 2048; }
template <int OFFS> __device__ __forceinline__ s16x4 tr_read(int vb) {
  s16x4 r; asm volatile("ds_read_b64_tr_b16 %0, %1 offset:%2" : "=&v"(r) : "v"(vb), "i"(OFFS) : "memory"); return r;
}
template <int D0> __device__ __forceinline__ void pv_one(f32x16& od, int vb, bf16x8 pa0, bf16x8 pa1, bf16x8 pa2, bf16x8 pa3) {
  const s16x4 l0 = tr_read<v_rd_off(D0, 0, 0)>(vb), h0 = tr_read<v_rd_off(D0, 0, 1)>(vb), l1 = tr_read<v_rd_off(D0, 1, 0)>(vb), h1 = tr_read<v_rd_off(D0, 1, 1)>(vb);
  const s16x4 l2 = tr_read<v_rd_off(D0, 2, 0)>(vb), h2 = tr_read<v_rd_off(D0, 2, 1)>(vb), l3 = tr_read<v_rd_off(D0, 3, 0)>(vb), h3 = tr_read<v_rd_off(D0, 3, 1)>(vb);
  asm volatile("s_waitcnt lgkmcnt(0)" ::: "memory"); SBAR();
#define PK(Lx, Hx) (bf16x8){Lx[0], Lx[1], Lx[2], Lx[3], Hx[0], Hx[1], Hx[2], Hx[3]}
  od = __builtin_amdgcn_mfma_f32_32x32x16_bf16(pa0, PK(l0, h0), od, 0, 0, 0);
  od = __builtin_amdgcn_mfma_f32_32x32x16_bf16(pa1, PK(l1, h1), od, 0, 0, 0);
  od = __builtin_amdgcn_mfma_f32_32x32x16_bf16(pa2, PK(l2, h2), od, 0, 0, 0);
  od = __builtin_amdgcn_mfma_f32_32x32x16_bf16(pa3, PK(l3, h3), od, 0, 0, 0);
#undef PK
}
__device__ __forceinline__ void pv_d0(f32x16* o, int vb, bf16x8 pa0, bf16x8 pa1, bf16x8 pa2, bf16x8 pa3) {
  pv_one<0>(o[0], vb, pa0, pa1, pa2, pa3); pv_one<1>(o[1], vb, pa0, pa1, pa2, pa3); pv_one<2>(o[2], vb, pa0, pa1, pa2, pa3); pv_one<3>(o[3], vb, pa0, pa1, pa2, pa3);
}
__device__ __forceinline__ void attn_unit(const bf16* __restrict__ Qb, const bf16* __restrict__ Kh, const bf16* __restrict__ Vh,
                                          const bf16* __restrict__ Gb, bf16* __restrict__ Ob, int seq, char* lds, const int tid) {
  const int wid = tid >> 6, lane = tid & 63, r32 = lane & 31, hi = lane >> 5;
  bf16* V_lds = (bf16*)lds; bf16* K_lds = (bf16*)(lds + 2 * SHM_V);
  float* ws = (float*)(lds + 2 * SHM_V + 2 * SHM_K) + wid * 64; float* li_l = ws; float* al_l = ws + 32;
  float m_reg = -1e30f, l_reg = 0; f32x16 o[4] = {}; bf16x8 qr[8];
  const bf16* Qw = Qb + (long)(wid * QBLK + r32) * LDQ + hi * 8;
#pragma unroll
  for (int d0 = 0; d0 < 8; ++d0) qr[d0] = *reinterpret_cast<const bf16x8*>(Qw + d0 * 16);
  const int sr = tid >> 4, sc = (tid & 15) * 8, vst0 = v_st(sr, sc), vst1 = v_st(32 + sr, sc);
  const int vb0 = (int)(uintptr_t)V_lds + v_rd_base(lane);
  struct { bf16x8 vs0, vs1, ks0, ks1; } sr_[2];
#define SLOAD(i, k0) do { sr_[i].vs0 = *(const bf16x8*)(&Vh[(long)((k0) + sr) * LDK + sc]); sr_[i].vs1 = *(const bf16x8*)(&Vh[(long)((k0) + 32 + sr) * LDK + sc]); \
    sr_[i].ks0 = *(const bf16x8*)(&Kh[(long)((k0) + sr) * LDK + sc]); sr_[i].ks1 = *(const bf16x8*)(&Kh[(long)((k0) + 32 + sr) * LDK + sc]); } while (0)
#define SWRITE(b, i) do { *(bf16x8*)((char*)V_lds + (b) * SHM_V + vst0) = sr_[i].vs0;          \
    *(bf16x8*)((char*)V_lds + (b) * SHM_V + vst1) = sr_[i].vs1; int kc = sc * 2;               \
    *(bf16x8*)((char*)K_lds + (b) * SHM_K + KSWZ(sr, kc)) = sr_[i].ks0;                       \
    *(bf16x8*)((char*)K_lds + (b) * SHM_K + KSWZ(32 + sr, kc)) = sr_[i].ks1; } while (0)
#define SWAIT() asm volatile("s_waitcnt vmcnt(4)" ::: "memory")
#define RESC(av) do { if (__any((av) < 1.f)) { if (hi == 0) al_l[r32] = (av); asm volatile("s_waitcnt lgkmcnt(0)" ::: "memory"); \
    for (int d = 0; d < 4; ++d) for (int r = 0; r < 16; ++r) o[d][r] *= al_l[crow(r, hi)]; } } while (0)
  f32x16 pA0, pA1, pB0, pB1; float mnA, mnB, alA, alB; bf16x8 pa0, pa1, pa2, pa3; const int NT = seq / KVBLK;
  constexpr int SE = 0, SO = 1;
  SLOAD(SE, 0); asm volatile("s_waitcnt vmcnt(0)" ::: "memory"); SWRITE(0, SE); __syncthreads();
  qkt(pA0, pA1, K_lds, qr, r32, hi); partialSM(pA0, pA1, m_reg, mnA, alA);
  SLOAD(SO, KVBLK); if (2 < NT) SLOAD(SE, 2 * KVBLK);
  SWAIT(); SWRITE(1, SO); __syncthreads();
  for (int j = 1; j + 1 < NT; j += 2) {
    SBAR(); qkt(pB0, pB1, (bf16*)((char*)K_lds + SHM_K), qr, r32, hi);
    finishSM(pA0, pA1, alA, l_reg, pa0, pa1, pa2, pa3); SBAR();
    SLOAD(SO, (j + 2) * KVBLK); SBAR();
    pv_d0(o, vb0, pa0, pa1, pa2, pa3); partialSM(pB0, pB1, m_reg, mnB, alB);
    __syncthreads(); SWAIT(); SWRITE(0, SE);
    RESC(alB); __syncthreads();
    SBAR(); qkt(pA0, pA1, K_lds, qr, r32, hi);
    finishSM(pB0, pB1, alB, l_reg, pa0, pa1, pa2, pa3); SBAR();
    if (j + 3 < NT) SLOAD(SE, (j + 3) * KVBLK); SBAR();
    pv_d0(o, vb0 + (int)SHM_V, pa0, pa1, pa2, pa3); partialSM(pA0, pA1, m_reg, mnA, alA);
    __syncthreads(); SWAIT(); SWRITE(1, SO);
    RESC(alA); __syncthreads();
  }
  SBAR(); qkt(pB0, pB1, (bf16*)((char*)K_lds + SHM_K), qr, r32, hi);
  finishSM(pA0, pA1, alA, l_reg, pa0, pa1, pa2, pa3); SBAR();
  pv_d0(o, vb0, pa0, pa1, pa2, pa3); partialSM(pB0, pB1, m_reg, mnB, alB);
  __syncthreads(); RESC(alB);
  finishSM(pB0, pB1, alB, l_reg, pa0, pa1, pa2, pa3); SBAR();
  pv_d0(o, vb0 + (int)SHM_V, pa0, pa1, pa2, pa3);
  if (hi == 0) li_l[r32] = l_reg; asm volatile("s_waitcnt lgkmcnt(0)" ::: "memory"); SBAR();
  float rli[16];
#pragma unroll
  for (int r = 0; r < 16; ++r) rli[r] = __builtin_amdgcn_rcpf(li_l[crow(r, hi)]);
  long go = (long)(wid * QBLK + 4 * hi) * LDQ + r32, oo = (long)(wid * QBLK + 4 * hi) * 2048 + r32;
#pragma unroll
  for (int r = 0; r < 16; ++r) {
#pragma unroll
    for (int d0 = 0; d0 < 4; ++d0) { const float g = bf2f(Gb[go + d0 * 32]); Ob[oo + d0 * 32] = (bf16)f2bf(o[d0][r] * rli[r] * silu_f(g)); }
    const int step = ((r & 3) == 3) ? 5 : 1; go += step * LDQ; oo += step * 2048;
    asm volatile("" : "+v"(go), "+v"(oo) :: "memory"); }
  __syncthreads();
#undef SLOAD
#undef SWRITE
#undef SWAIT
#undef RESC
}
}

__device__ __forceinline__ void phase_ytr(const Args& a, char* lds, int tid, int G) {
    const bf16* YT = (const bf16*)(a.ws + WS_YT); bf16* MIX = (bf16*)(a.ws + WS_MIX);
    constexpr int TS = 144;
    for (int item = blockIdx.x; item < 576 * 2; item += G) {
        const int rt = item >> 1, ct = item & 1, r0 = rt * 64, c0 = ct * 256;
        __syncthreads();
        { const int ch = tid >> 3, part = tid & 7; u32x4 w[4];
#pragma unroll
          for (int i = 0; i < 4; ++i) w[i] = *(const u32x4*)(YT + (size_t)(c0 + ch + 64 * i) * MROWS + r0 + 8 * part);
#pragma unroll
          for (int i = 0; i < 4; ++i) *(u32x4*)(lds + (ch + 64 * i) * TS + ((part ^ ((ch >> 3) & 7)) * 16)) = w[i]; }
        __syncthreads();
#pragma unroll
        for (int i = 0; i < 4; ++i) { const int id = tid + 512 * i, r = id >> 5, cp = id & 31; unsigned short v[8];
#pragma unroll
          for (int j = 0; j < 8; ++j) v[j] = *(const unsigned short*)(lds + (8 * cp + j) * TS + ((((r >> 3) ^ (cp & 7)) * 16) + (r & 7) * 2));
          u32x4 w; w.x = v[0] | ((unsigned)v[1] << 16); w.y = v[2] | ((unsigned)v[3] << 16); w.z = v[4] | ((unsigned)v[5] << 16); w.w = v[6] | ((unsigned)v[7] << 16);
          *(u32x4*)(MIX + (size_t)(r0 + r) * 2048 + c0 + 8 * cp) = w; }
    }
    __syncthreads();
}

template <int SEL> __device__ __forceinline__ void phase_mix(const Args& a, int l, char* lds, int tid_in, int G) {
    const bf16* P = (const bf16*)(a.ws + WS_P); bf16* MIX = (bf16*)(a.ws + WS_MIX);
    const bf16* KL = (const bf16*)(a.ws + WS_KL); const bf16* VL = (const bf16*)(a.ws + WS_VL); const bf16* KP = (const bf16*)(a.ws + WS_KP); const bf16* VP = (const bf16*)(a.ws + WS_VP);
    constexpr int N_HS = 512, N_AS = 1024, N_HP = 512, N_AP = 128, N_ALL = N_HS + N_AS + N_HP + N_AP;
    const int nround = (N_ALL + G - 1) / G; const bool swp = (SEL == 0xF) && (G == 256);
    for (int kr = 0; kr < nround; ++kr) {
        const int kk = (swp && kr < 4) ? ((kr + (int)(blockIdx.x & 3)) & 3) : kr; const int item = blockIdx.x + kk * G; if (item >= N_ALL) continue;
        int r = item;
        int tid = tid_in; asm volatile("" : "+v"(tid));
        const int lane = tid & 63, wave = __builtin_amdgcn_readfirstlane(tid >> 6);
#define HY_CH(r) ((((r) & 7) << 5) | (((r) >> 3) & 31) | ((r) & 256))
        if (r < N_HS) { if ((PMASK & 256) && (SEL & 1)) hyena_item<4096, 64, 1, (SEL == 1 ? HYABL : 0)>(a, l, HY_CH(r), lds, tid, lane, wave); continue; } r -= N_HS;
        if (r < N_AS + N_HP) {
            if (r >= N_AS) { if ((PMASK & 1024) && (SEL & 4)) hyena_item<256, 32, 2>(a, l, HY_CH(r - N_AS), lds, tid, lane, wave); continue; } }
        else r -= N_HP;
        if ((PMASK & 512) && (r < N_AS ? (SEL & 2) : (SEL & 8))) {
            const bool lat = r < N_AS; const int rp = r - N_AS;
            const int h = lat ? (r >> 4) & 7 : (rp & 7), b = lat ? (r >> 7) : (rp >> 3), kvh = h >> 2;
            const size_t row0 = lat ? (size_t)MP + b * 4096 + (r & 15) * 256 : (size_t)b * 256;
            const int seq = lat ? SKV_S : LP;
            const bf16* Kb = (lat ? KL : KP) + (size_t)(b * 2 + kvh) * seq * 128; const bf16* Vb = (lat ? VL : VP) + (size_t)(b * 2 + kvh) * seq * 128;
            attn::attn_unit(P + row0 * PST + C_Q + h * 128, Kb, Vb, P + row0 * PST + C_ATG + h * 128, MIX + row0 * 2048 + 1024 + h * 128, seq, lds, tid);
        }
    }
    __syncthreads();
}


#define LAS __attribute__((address_space(3)))
#define XB_TMO      128
#define XB_XCNT(j)  (256  + 64 * (j))
#define XB_XSUB(j)  (1280 + 64 * (j))
#define XB_XGEN(j)  (2304 + 64 * (j))
#define XB_TOP      3328
#define XB_TOPGEN   3392
#define XCD_BAR_WORDS 3456
#define XB_SPIN_CAP (1u << 22)
__device__ __forceinline__ unsigned xb_ld(unsigned* p)              { return __hip_atomic_load(p, __ATOMIC_RELAXED, __HIP_MEMORY_SCOPE_AGENT); }
__device__ __forceinline__ unsigned xb_add(unsigned* p, unsigned v) { return __hip_atomic_fetch_add(p, v, __ATOMIC_RELAXED, __HIP_MEMORY_SCOPE_AGENT); }
__device__ __forceinline__ unsigned xb_xcc_id() { return (unsigned)__builtin_amdgcn_s_getreg((3 << 11) | 20) & 0xFu; }
#define XB_SPIN(cond, bar) do { unsigned _sp = 0; while (cond) { __builtin_amdgcn_s_sleep(1); \
    if ((++_sp & 255u) == 0u) { if (xb_ld(&(bar)[XB_TMO])) break; if (_sp > XB_SPIN_CAP) { atomicAdd(&(bar)[XB_TMO], 1u); break; } } } } while (0)
struct XcdBarrier { unsigned* bar; unsigned x; volatile LAS unsigned* st; };
__device__ __forceinline__ XcdBarrier xcd_barrier_post(unsigned* bar, volatile LAS unsigned* st) {
    XcdBarrier b; b.bar = bar; b.x = xb_xcc_id(); b.st = st;
    if (threadIdx.x == 0) (void)xb_add(&bar[XB_XCNT(b.x)], 1u);
    return b;
}
__device__ __forceinline__ void xcd_barrier_complete(unsigned* bar, unsigned x, unsigned& nloc, unsigned& nx) {
    const unsigned G = gridDim.x * gridDim.y * gridDim.z;
    unsigned sum, cnt, mine, sp = 0u;
    for (;;) {
        sum = 0u; cnt = 0u; mine = 0u;
#pragma unroll
        for (unsigned j = 0; j < 16; ++j) { const unsigned c = xb_ld(&bar[XB_XCNT(j)]); sum += c; cnt += (c > 0u) ? 1u : 0u; mine = (j == x) ? c : mine; }
        if (sum == G) break;
        __builtin_amdgcn_s_sleep(1);
        if ((++sp & 255u) == 0u) { if (xb_ld(&bar[XB_TMO])) break; if (sp > XB_SPIN_CAP) { atomicAdd(&bar[XB_TMO], 1u); break; } }
    }
    nloc = mine > 0u ? mine : 1u; nx = cnt > 0u ? cnt : 1u;
}
__device__ __forceinline__ void xcd_barrier(const XcdBarrier& b) {
    asm volatile("s_waitcnt vmcnt(0)" ::: "memory");
    __syncthreads();
    if (threadIdx.x == 0) {
        unsigned* bar = b.bar;
        __builtin_amdgcn_s_waitcnt(0);
        unsigned nloc = b.st[0], nx = b.st[1];
        if (nloc == 0u) { xcd_barrier_complete(bar, b.x, nloc, nx); b.st[0] = nloc; b.st[1] = nx; }
        const unsigned old = xb_add(&bar[XB_XSUB(b.x)], 1u);
        const unsigned gen = old / nloc;
        if (old + 1u == (gen + 1u) * nloc) {
            __builtin_amdgcn_fence(__ATOMIC_RELEASE, "agent");
            asm volatile("s_waitcnt vmcnt(0)" ::: "memory");
            const unsigned og = xb_add(&bar[XB_TOP], 1u);
            const unsigned tg = og / nx;
            if (og + 1u == (tg + 1u) * nx) xb_add(&bar[XB_TOPGEN], 1u);
            else XB_SPIN(xb_ld(&bar[XB_TOPGEN]) == tg, bar);
            __builtin_amdgcn_fence(__ATOMIC_ACQUIRE, "agent");
            xb_add(&bar[XB_XGEN(b.x)], 1u);
            asm volatile("s_waitcnt vmcnt(0)" ::: "memory");
        } else {
            XB_SPIN(xb_ld(&bar[XB_XGEN(b.x)]) == gen, bar);
            __builtin_amdgcn_fence(__ATOMIC_ACQUIRE, "agent");
            asm volatile("s_waitcnt vmcnt(0)" ::: "memory");
        }
    }
    __syncthreads();
}

constexpr int N_PHASES = 2 + 6 * NL;
__global__ void __launch_bounds__(512) fwd_megakernel(Args args_unused) {
    extern __shared__ __attribute__((aligned(16))) unsigned char lds_raw[];
    char* lds = (char*)lds_raw;
    const int G = gridDim.x;
    int lo, hi; unsigned* barw; { const Args a0 = load_args(); lo = a0.ph_lo; hi = a0.ph_hi; barw = (unsigned*)a0.ws; }
    volatile LAS unsigned* bst = (volatile LAS unsigned*)((LAS unsigned char*)lds_raw + (LDS_BYTES - 64));
    if (threadIdx.x < 16) bst[threadIdx.x] = 0u;
    __syncthreads();
    XcdBarrier xbar; xbar.bar = barw; xbar.x = 0; xbar.st = bst;
    if (hi - lo > 1) xbar = xcd_barrier_post(barw, bst);
    int ph = 0;
#define RUN(...) do { if (lo <= ph && ph < hi) { int tid = threadIdx.x; asm volatile("" : "+v"(tid)); const int lane = tid & 63, wave = __builtin_amdgcn_readfirstlane(tid >> 6); \
        const Args args = load_args(); (void)lane; (void)wave; __VA_ARGS__; \
        if (ph + 1 < hi) { if (hi == 0x7ffffff0) { asm volatile("s_waitcnt vmcnt(0)" ::: "memory"); __syncthreads(); cg::this_grid().sync(); } else xcd_barrier(xbar); } } ++ph; } while (0)
#define PM(b, ...) do { if (PMASK & (1 << b)) { __VA_ARGS__; } } while (0)
    RUN({ PM(0, phase0(args, lds, tid, lane, wave, G)); if (DUP & 16) { __syncthreads(); phase0(args, lds, tid, lane, wave, G); } });
    RUN({ PM(1, phase_filt2(args, lds, tid, G)); if (DUP & 16) phase_filt2(args, lds, tid, G); PM(2, phase_adaln(args, 0, lane, wave, G)); if (DUP & 64) { for (int i = 0; i < 40; ++i) xcd_barrier(xbar); } });
#pragma unroll 1
    for (int l = 0; l < NL; ++l) {
        RUN(PM(3, { pg8::Gemm g{(const bf16*)(args.ws + WS_H), (const bf16*)(args.ws + WS_WIN) + (size_t)l * 6144 * 2048, MROWS, DIN, DM};
              pg8::StaticOrder S; S.init(MROWS, DIN, G, (int)blockIdx.x);
              pg8::EpiIn E{(bf16*)(args.ws + WS_P), (bf16*)(args.ws + WS_ZT), MROWS};
              pg8::gemm_phase<pg8::EpiIn, pg8::StaticOrder, true, true>((PG8_LAS unsigned char*)lds_raw, g, S, E, tid);
              if (DUP & 1) pg8::gemm_phase<pg8::EpiIn, pg8::StaticOrder, true, true>((PG8_LAS unsigned char*)lds_raw, g, S, E, tid); }));
        RUN({ PM(5, prep_qkv(args, l, lane, wave, G)); });
        RUN({ PM(6, prep_chunkmlp(args, l, lds, tid, lane, wave, G)); if (DUP & 32) { prep_chunkmlp(args, l, lds, tid, lane, wave, G); }
              PM(7, phase_mix<0xF>(args, l, lds, tid, G)); if (DUP & 2) phase_mix<0x1>(args, l, lds, tid, G); if (DUP & 4) phase_mix<0x2>(args, l, lds, tid, G); if (DUP & 8) phase_mix<0xC>(args, l, lds, tid, G); });
        RUN({ phase_ytr(args, lds, tid, G); if (DUP & 1024) phase_ytr(args, lds, tid, G); });
        RUN(PM(3, { pg8::Gemm g{(const bf16*)(args.ws + WS_MIX), (const bf16*)(args.ws + WS_WOUT) + (size_t)l * 2048 * 2048, MROWS, DM, DM};
              pg8::StaticOrder S; S.init(MROWS, DM, G, (int)blockIdx.x);
              pg8::EpiResid E{l, ALPHA, 0};
              if (DUP & 256) { pg8::EpiResid E2{l, ALPHA, 1}; pg8::gemm_phase<pg8::EpiResid, pg8::StaticOrder, true, true>((PG8_LAS unsigned char*)lds_raw, g, S, E2, tid); }
              pg8::gemm_phase<pg8::EpiResid, pg8::StaticOrder, true, true>((PG8_LAS unsigned char*)lds_raw, g, S, E, tid); }));
        RUN({ PM(2, phase_adaln(args, l + 1, lane, wave, G)); if ((DUP & 128) && l + 1 < NL) phase_adaln(args, l + 1, lane, wave, G); });
    }
#undef RUN
}

extern "C" void kernel_launch(void* const* d_in, const int* in_sizes, int n_in, void* d_out, int out_size, void* d_ws, size_t ws_size, hipStream_t stream) {
    static int grid = 0;
    if (grid == 0) {
        if (n_in != 27 || ws_size < WS_END) { fprintf(stderr, "kernel_launch: unexpected n_in %d / ws_size %zu\n", n_in, ws_size); grid = -1; return; }
        int dev = 0, cus = 0, per_cu = 0;
        (void)hipGetDevice(&dev); (void)hipDeviceGetAttribute(&cus, hipDeviceAttributeMultiprocessorCount, dev);
        if (hipFuncSetAttribute((const void*)fwd_megakernel, hipFuncAttributeMaxDynamicSharedMemorySize, LDS_BYTES) != hipSuccess) { fprintf(stderr, "kernel_launch: hipFuncSetAttribute failed\n"); grid = -1; return; }
        if (hipOccupancyMaxActiveBlocksPerMultiprocessor(&per_cu, (const void*)fwd_megakernel, 512, LDS_BYTES) != hipSuccess || per_cu < 1) per_cu = 1;
        (void)hipGetLastError();
        grid = cus * 1;
        fprintf(stderr, "kernel_launch: cus %d per_cu %d grid %d\n", cus, per_cu, grid);
    }
    if (grid < 0) return;
    if (hipMemsetAsync(d_ws, 0, 16384, stream) != hipSuccess) { fprintf(stderr, "kernel_launch: memset failed\n"); return; }
    Args a{};
    for (int i = 0; i < 27; ++i) a.in[i] = (const float*)d_in[i];
    a.out = (float*)d_out; a.ws = (unsigned char*)d_ws;
#if MULTI_LAUNCH
    for (int p = 0; p < N_PHASES; ++p) { a.ph_lo = p; a.ph_hi = p + 1; hipLaunchKernelGGL(fwd_megakernel, dim3(grid), dim3(512), LDS_BYTES, stream, a); }
#else
    a.ph_lo = 0; a.ph_hi = N_PHASES;
    void* kargs[] = {&a};
    hipError_t e = hipLaunchCooperativeKernel((const void*)fwd_megakernel, dim3(grid), dim3(512), kargs, LDS_BYTES, stream);
    if (e != hipSuccess) fprintf(stderr, "cooperative launch failed: %s (grid %d)\n", hipGetErrorString(e), grid);
#endif
}
```

```cpp
#include <hip/hip_runtime.h>
#include <hip/hip_cooperative_groups.h>
#include <cstdio>
#include <cstdint>
namespace cg = cooperative_groups;

#ifndef MULTI_LAUNCH
#define MULTI_LAUNCH 0
#endif
#ifndef PMASK
#define PMASK 0xFFF
#endif
#ifndef DUP
#define DUP 0
#endif
#ifndef HYABL
#define HYABL 0
#endif

struct Args {
    const float* in[27]; float* out; unsigned char* ws; int ph_lo, ph_hi;
};
typedef const __attribute__((address_space(4))) Args* KArgsP;
template <class T> __device__ __forceinline__ T* as_global(T* p) { return (T*)(__attribute__((address_space(1))) T*)p; }
__device__ __forceinline__ Args load_args() {
    KArgsP kp = (KArgsP)__builtin_amdgcn_kernarg_segment_ptr();
    asm volatile("" : "+s"(kp));
    Args a;
#pragma unroll
    for (int i = 0; i < 27; ++i) a.in[i] = as_global(kp->in[i]);
    a.out = as_global(kp->out); a.ws = as_global(kp->ws); a.ph_lo = kp->ph_lo; a.ph_hi = kp->ph_hi;
    return a;
}
namespace pg8 {
#define PG8_LAS __attribute__((address_space(3)))
typedef unsigned short bf16_t;
typedef short bf16x8 __attribute__((ext_vector_type(8)));
typedef float f32x4 __attribute__((ext_vector_type(4)));
typedef unsigned u32x4 __attribute__((ext_vector_type(4)));
constexpr int BM = 256, BK = 64, HALF = 128, HTB = HALF * BK * 2, STAGE_BYTES = 8 * HTB, NXCD = 8, WGM = 8;

__host__ __device__ __forceinline__ int lds_byte(int r, int c) { const int st = (r >> 4) * 2 + (c >> 5), rr = r & 15, cc = c & 31, ob = rr * 64 + cc * 2; return st * 1024 + (ob ^ (((ob >> 9) & 1) << 5)); }
__host__ __device__ __forceinline__ void stage_rc(int b, int& R, int& C) { const int st = b / 1024, sb = b % 1024, swz = sb ^ (((sb >> 9) & 1) << 5); R = (st >> 1) * 16 + swz / 64; C = (st & 1) * 32 + (swz % 64) / 2; }
__host__ __device__ __forceinline__ int perm32(int rho) { const int n = rho >> 4, i = rho & 15; return 8 * (i >> 2) + 4 * n + (i & 3); }

struct Unit { int pm, pn; };
struct Gemm { const bf16_t* A; const bf16_t* Bt; int M, N, K; };

struct StaticOrder {
    int nM, nN, nwg, G, c;
    __host__ __device__ void init(int M, int N, int G_, int c_) { nM = M / BM; nN = N / BM; nwg = nM * nN; G = G_; c = c_; }
    __host__ __device__ bool next(int i, Unit& u) const {
        const long L = (long)i * G + c; if (L >= nwg) return false;
        int wgid = (int)L; { const int q = nwg / NXCD, r = nwg % NXCD, xcd = wgid % NXCD, off = wgid / NXCD; wgid = (xcd < r ? xcd * (q + 1) : r * (q + 1) + (xcd - r) * q) + off; }
        const int nig = WGM * nN, gid = wgid / nig, fm = gid * WGM, gsz = (nM - fm) < WGM ? (nM - fm) : WGM;
        u.pm = fm + ((wgid % nig) % gsz); u.pn = (wgid % nig) / gsz; return true;
    }
    __device__ __forceinline__ void a_ready(const Unit&) const {}
    __device__ __forceinline__ void done(const Unit&) const {}
};

__device__ __forceinline__ unsigned cvt_pk_bf16(float lo, float hi) { unsigned r; asm volatile("v_cvt_pk_bf16_f32 %0, %1, %2" : "=v"(r) : "v"(lo), "v"(hi)); return r; }

struct EpiBf16 {
    static constexpr bool PERM = true, AFTER_DRAIN = false;
    bf16_t* O; int ldc;
    __device__ __forceinline__ void operator()(const f32x4 (&acc)[2][2][4][2], const Unit& u, int wr, int wc, int fr, int fq) const {
        const int row0 = u.pm * BM + wr * 64 + fr; const int col0 = u.pn * BM + wc * 32 + 8 * fq;
#pragma unroll
        for (int ai = 0; ai < 2; ++ai)
#pragma unroll
            for (int m = 0; m < 4; ++m) { bf16_t* rowp = O + (size_t)(row0 + ai * HALF + m * 16) * ldc + col0;
#pragma unroll
                for (int bj = 0; bj < 2; ++bj) { const f32x4 v0 = acc[ai][bj][m][0], v1 = acc[ai][bj][m][1];
                    u32x4 w; w.x = cvt_pk_bf16(v0[0], v0[1]); w.y = cvt_pk_bf16(v0[2], v0[3]); w.z = cvt_pk_bf16(v1[0], v1[1]); w.w = cvt_pk_bf16(v1[2], v1[3]);
                    *(u32x4*)(rowp + bj * HALF) = w; } }
    }
};
struct EpiIn {
    static constexpr bool PERM = true, AFTER_DRAIN = false;
    bf16_t* O; bf16_t* ZT; int nrows;
    __device__ __forceinline__ void operator()(const f32x4 (&acc)[2][2][4][2], const Unit& u, int wr, int wc, int fr, int fq) const {
        const int row0 = u.pm * BM + wr * 64 + fr;
        if (u.pn >= 8) {
            const int col0 = (u.pn - 8) * BM + wc * 32 + 8 * fq;
#pragma unroll
            for (int ai = 0; ai < 2; ++ai)
#pragma unroll
                for (int m = 0; m < 4; ++m) { bf16_t* rowp = O + (size_t)(row0 + ai * HALF + m * 16) * 4096 + col0;
#pragma unroll
                    for (int bj = 0; bj < 2; ++bj) { const f32x4 v0 = acc[ai][bj][m][0], v1 = acc[ai][bj][m][1];
                        u32x4 w; w.x = cvt_pk_bf16(v0[0], v0[1]); w.y = cvt_pk_bf16(v0[2], v0[3]); w.z = cvt_pk_bf16(v1[0], v1[1]); w.w = cvt_pk_bf16(v1[2], v1[3]);
                        *(u32x4*)(rowp + bj * HALF) = w; } }
        } else {
            const int col0 = u.pn * BM + wc * 32 + 8 * fq;
            long zo = (long)col0 * nrows + row0;
#pragma unroll
            for (int ai = 0; ai < 2; ++ai)
#pragma unroll
                for (int m = 0; m < 4; ++m) {
#pragma unroll
                    for (int bj = 0; bj < 2; ++bj) { const f32x4 v0 = acc[ai][bj][m][0], v1 = acc[ai][bj][m][1];
                        const unsigned w0 = cvt_pk_bf16(v0[0], v0[1]), w1 = cvt_pk_bf16(v0[2], v0[3]), w2 = cvt_pk_bf16(v1[0], v1[1]), w3 = cvt_pk_bf16(v1[2], v1[3]);
                        bf16_t* zp = ZT + zo + (long)(bj * HALF) * nrows + (ai * HALF + m * 16);
                        zp[0] = (bf16_t)w0; zp[(long)nrows] = (bf16_t)(w0 >> 16); zp[2L * nrows] = (bf16_t)w1; zp[3L * nrows] = (bf16_t)(w1 >> 16);
                        zp[4L * nrows] = (bf16_t)w2; zp[5L * nrows] = (bf16_t)(w2 >> 16); zp[6L * nrows] = (bf16_t)w3; zp[7L * nrows] = (bf16_t)(w3 >> 16); }
                    asm volatile("" : "+v"(zo) :: "memory"); }
        }
    }
};
struct EpiResid {
    static constexpr bool PERM = true, AFTER_DRAIN = false;
    int l; float alpha; int dup;
    __device__ __forceinline__ void operator()(const f32x4 (&acc)[2][2][4][2], const Unit& u, int wr, int wc, int fr, int fq) const {
        const Args a = load_args();
        bf16_t* Ub = (bf16_t*)a.out; float* Xf = (float*)(a.ws + (312u << 20)); const float* xin_p = a.in[0]; const float* xin_s = a.in[1]; const float* stats = (const float*)(a.ws + (936u << 20));
        const int use_ln = l > 0; const bool last = (l == 3); const float* lng = a.in[25] + (use_ln ? (l - 1) * 2048 : 0); const float* lnb = a.in[26] + (use_ln ? (l - 1) * 2048 : 0);
        const float* modl = (const float*)(a.ws + (1u << 20)) + (size_t)l * 9 * 6144;
        const int row0 = u.pm * BM + wr * 64 + fr; const int col0 = u.pn * BM + wc * 32 + 8 * fq;
        const int cond = (u.pm < 16) ? 8 : ((u.pm - 16) >> 4);
        const float* gate = modl + cond * 6144 + 4096 + col0;
        const float* src = (u.pm < 16 ? xin_p : xin_s); const int roff = (u.pm < 16) ? 0 : -4096;
        f32x4 gv[2][2], lg[2][2], lb[2][2];
#pragma unroll
        for (int bj = 0; bj < 2; ++bj)
#pragma unroll
            for (int n = 0; n < 2; ++n) { gv[bj][n] = *(const f32x4*)(gate + bj * HALF + n * 4);
                if (use_ln) { lg[bj][n] = *(const f32x4*)(lng + col0 + bj * HALF + n * 4); lb[bj][n] = *(const f32x4*)(lnb + col0 + bj * HALF + n * 4); }
                else { lg[bj][n] = (f32x4){1.f, 1.f, 1.f, 1.f}; lb[bj][n] = (f32x4){0.f, 0.f, 0.f, 0.f}; } }
#pragma unroll
        for (int ai = 0; ai < 2; ++ai)
#pragma unroll
            for (int m = 0; m < 4; ++m) { const int row = row0 + ai * HALF + m * 16;
                float mu = 0.f, rs = 1.f; if (use_ln) { const float* sp = stats + 2 * (size_t)row; mu = sp[0]; rs = sp[1]; }
                const float* sp2 = src + (size_t)(row + roff) * 2048 + col0; bf16_t* up = Ub + (size_t)row * 2048 + col0; float* xp = Xf + (size_t)row * 2048 + col0;
#pragma unroll
                for (int bj = 0; bj < 2; ++bj) { f32x4 x0, x1;
                    if (use_ln) { const u32x4 w = *(const u32x4*)(up + bj * HALF);
                        x0 = (f32x4){__builtin_bit_cast(float, w.x << 16), __builtin_bit_cast(float, w.x & 0xffff0000u), __builtin_bit_cast(float, w.y << 16), __builtin_bit_cast(float, w.y & 0xffff0000u)};
                        x1 = (f32x4){__builtin_bit_cast(float, w.z << 16), __builtin_bit_cast(float, w.z & 0xffff0000u), __builtin_bit_cast(float, w.w << 16), __builtin_bit_cast(float, w.w & 0xffff0000u)}; }
                    else { x0 = *(const f32x4*)(sp2 + bj * HALF); x1 = *(const f32x4*)(sp2 + bj * HALF + 4); }
                    x0 = (x0 - mu) * rs * lg[bj][0] + lb[bj][0]; x1 = (x1 - mu) * rs * lg[bj][1] + lb[bj][1];
                    x0 = x0 * alpha + gv[bj][0] * acc[ai][bj][m][0]; x1 = x1 * alpha + gv[bj][1] * acc[ai][bj][m][1];
                    if (dup) { *(f32x4*)(xp + bj * HALF) = x0; *(f32x4*)(xp + bj * HALF + 4) = x1; }
                    else { bf16_t* wp = last ? (bf16_t*)Xf + (size_t)row * 2048 + col0 : up; u32x4 o; o.x = cvt_pk_bf16(x0[0], x0[1]); o.y = cvt_pk_bf16(x0[2], x0[3]); o.z = cvt_pk_bf16(x1[0], x1[1]); o.w = cvt_pk_bf16(x1[2], x1[3]); *(u32x4*)(wp + bj * HALF) = o; } } }
    }
};

template <class Epi, class Sched, bool ALIGN_EPI = false, bool SP2 = false>
__device__ __forceinline__ void gemm_phase(PG8_LAS unsigned char* lds, const Gemm g, const Sched& S, const Epi& E, const int tid) {
    const int wid = __builtin_amdgcn_readfirstlane(tid >> 6), lane = tid & 63, wr = wid >> 2, wc = wid & 3, fr = lane & 15, fq = lane >> 4;
    const int K = g.K, nt = K / BK;
    unsigned voffA[2], voffB[2];
#pragma unroll
    for (int i = 0; i < 2; ++i) { int R, C; stage_rc(tid * 16 + i * 8192, R, C); const int Rb = Epi::PERM ? ((R & ~31) + perm32(R & 31)) : R;
        voffA[i] = (unsigned)(R * K + C) * 2u; voffB[i] = (unsigned)(Rb * K + C) * 2u; }
    const size_t kstep = (size_t)(BK * 2);
    const size_t hstep = (size_t)HALF * K * 2;
    const size_t tstep = 2 * hstep;
    const unsigned ldsw = (unsigned)wid * 1024u;
    const int aoff = lds_byte(wr * 64 + fr, fq * 8), boff = lds_byte(wc * 32 + fr, fq * 8);
#define PG8_SA(b, h) (((b) * 2 + (h)) * HTB)
#define PG8_SB(b, h) ((4 + (b) * 2 + (h)) * HTB)
#define PG8_STAGE(bufoff, gbase, voff) do { _Pragma("unroll") for (int _i = 0; _i < 2; ++_i) \
        __builtin_amdgcn_global_load_lds((const unsigned*)((const char*)(gbase) + (voff)[_i]), (PG8_LAS unsigned*)(lds + (bufoff) + ldsw + _i * 8192), 16, 0, 0); } while (0)
#define PG8_LDA(dst, b, h) do { _Pragma("unroll") for (int m = 0; m < 4; ++m) _Pragma("unroll") for (int k = 0; k < 2; ++k) dst[m][k] = *(const PG8_LAS bf16x8*)(lds + PG8_SA(b, h) + aoff + m * 2048 + k * 1024); } while (0)
#define PG8_LDB(dst, b, h) do { _Pragma("unroll") for (int n = 0; n < 2; ++n) _Pragma("unroll") for (int k = 0; k < 2; ++k) dst[n][k] = *(const PG8_LAS bf16x8*)(lds + PG8_SB(b, h) + boff + n * 2048 + k * 1024); } while (0)
#define PG8_MMA(ai, bj, At, Bt) do { __builtin_amdgcn_s_setprio(1); _Pragma("unroll") for (int m = 0; m < 4; ++m) _Pragma("unroll") for (int n = 0; n < 2; ++n) _Pragma("unroll") for (int k = 0; k < 2; ++k) \
        acc[ai][bj][m][n] = __builtin_amdgcn_mfma_f32_16x16x32_bf16(Bt[n][k], At[m][k], acc[ai][bj][m][n], 0, 0, 0); __builtin_amdgcn_s_setprio(0); } while (0)
#define PG8_WAIT_V(n) asm volatile("s_waitcnt vmcnt(" #n ")" ::: "memory")
#define PG8_WAIT_L(n) asm volatile("s_waitcnt lgkmcnt(" #n ")" ::: "memory")
#define PG8_BAR __builtin_amdgcn_s_barrier()
#define PG8_SCHED __builtin_amdgcn_sched_barrier(0)
    Unit cur, nxt; int ui = 0;
    if (!S.next(0, cur)) return;
    f32x4 acc[2][2][4][2];
#pragma unroll
    for (int a = 0; a < 2; ++a)
#pragma unroll
        for (int b = 0; b < 2; ++b)
#pragma unroll
            for (int m = 0; m < 4; ++m)
#pragma unroll
                for (int n = 0; n < 2; ++n) acc[a][b][m][n] = (f32x4){0.f, 0.f, 0.f, 0.f};
    bf16x8 At[4][2], B0[2][2], B1[2][2];
    const char* cA = (const char*)g.A + (size_t)cur.pm * tstep; const char* cB = (const char*)g.Bt + (size_t)cur.pn * tstep;
    S.a_ready(cur);
    if constexpr (SP2) {
        PG8_STAGE(PG8_SB(0, 0), cB, voffB); PG8_STAGE(PG8_SB(0, 1), cB + hstep, voffB); PG8_STAGE(PG8_SA(0, 0), cA, voffA); PG8_STAGE(PG8_SA(0, 1), cA + hstep, voffA);
        if (wr == 1) PG8_BAR;
        PG8_WAIT_V(2); PG8_BAR;
        PG8_STAGE(PG8_SB(1, 0), cB + kstep, voffB); PG8_STAGE(PG8_SA(1, 0), cA + kstep, voffA); PG8_STAGE(PG8_SB(1, 1), cB + hstep + kstep, voffB);
        PG8_WAIT_V(6); PG8_BAR;
    } else {
        PG8_STAGE(PG8_SB(0, 0), cB, voffB); PG8_STAGE(PG8_SA(0, 0), cA, voffA); PG8_STAGE(PG8_SB(0, 1), cB + hstep, voffB); PG8_STAGE(PG8_SA(0, 1), cA + hstep, voffA);
        if (wr == 1) PG8_BAR;
        PG8_WAIT_V(4); PG8_BAR;
        PG8_STAGE(PG8_SB(1, 0), cB + kstep, voffB); PG8_STAGE(PG8_SA(1, 0), cA + kstep, voffA); PG8_STAGE(PG8_SB(1, 1), cB + hstep + kstep, voffB);
        PG8_WAIT_V(6); PG8_BAR;
    }
    for (;;) {
        const bool has_next = S.next(ui + 1, nxt);
        const char* nA = has_next ? (const char*)g.A + (size_t)nxt.pm * tstep : cA; const char* nB = has_next ? (const char*)g.Bt + (size_t)nxt.pn * tstep : cB;
        for (int t = 0; t < nt; t += 2) {
            const bool last = (t == nt - 2);
            const char* a1 = cA + (size_t)(t + 1) * kstep;
            const char* a2 = last ? nA : cA + (size_t)(t + 2) * kstep; const char* b2 = last ? nB : cB + (size_t)(t + 2) * kstep;
            const char* a3 = a2 + kstep; const char* b3 = b2 + kstep;
            if (last && has_next) S.a_ready(nxt);
            if constexpr (SP2) {
            PG8_LDB(B0, 0, 0); PG8_LDB(B1, 0, 1); PG8_SCHED; PG8_LDA(At, 0, 0); PG8_STAGE(PG8_SA(1, 1), a1 + hstep, voffA);
            PG8_WAIT_V(8); PG8_WAIT_L(0); PG8_BAR; PG8_MMA(0, 0, At, B0); PG8_MMA(0, 1, At, B1); PG8_BAR; PG8_SCHED;
            PG8_LDA(At, 0, 1); PG8_STAGE(PG8_SB(0, 0), b2, voffB); PG8_STAGE(PG8_SB(0, 1), b2 + hstep, voffB); PG8_STAGE(PG8_SA(0, 0), a2, voffA);
            PG8_WAIT_V(8); PG8_WAIT_L(0); PG8_BAR; PG8_MMA(1, 0, At, B0); PG8_MMA(1, 1, At, B1); PG8_BAR; PG8_SCHED;
            PG8_LDB(B0, 1, 0); PG8_LDB(B1, 1, 1); PG8_SCHED; PG8_LDA(At, 1, 0); PG8_STAGE(PG8_SA(0, 1), a2 + hstep, voffA);
            PG8_WAIT_V(8); PG8_WAIT_L(0); PG8_BAR; PG8_MMA(0, 0, At, B0); PG8_MMA(0, 1, At, B1); PG8_BAR; PG8_SCHED;
            PG8_LDA(At, 1, 1); PG8_STAGE(PG8_SB(1, 0), b3, voffB); PG8_STAGE(PG8_SB(1, 1), b3 + hstep, voffB); PG8_STAGE(PG8_SA(1, 0), a3, voffA);
            PG8_WAIT_V(8); PG8_WAIT_L(0); PG8_BAR; PG8_MMA(1, 0, At, B0); PG8_MMA(1, 1, At, B1); PG8_BAR; PG8_SCHED;
            } else {
            PG8_LDB(B0, 0, 0); PG8_SCHED; PG8_LDA(At, 0, 0); PG8_STAGE(PG8_SA(1, 1), a1 + hstep, voffA);
            PG8_WAIT_L(8); PG8_BAR; PG8_WAIT_L(0); PG8_MMA(0, 0, At, B0); PG8_BAR; PG8_SCHED;
            PG8_LDB(B1, 0, 1); PG8_STAGE(PG8_SB(0, 0), b2, voffB);
            PG8_BAR; PG8_WAIT_L(0); PG8_MMA(0, 1, At, B1); PG8_BAR;
            PG8_LDA(At, 0, 1); PG8_STAGE(PG8_SA(0, 0), a2, voffA);
            PG8_BAR; PG8_WAIT_L(0); PG8_MMA(1, 0, At, B0); PG8_BAR; PG8_SCHED;
            PG8_STAGE(PG8_SB(0, 1), b2 + hstep, voffB);
            PG8_WAIT_V(6); PG8_BAR; PG8_MMA(1, 1, At, B1); PG8_BAR;
            PG8_LDB(B0, 1, 0); PG8_SCHED; PG8_LDA(At, 1, 0); PG8_STAGE(PG8_SA(0, 1), a2 + hstep, voffA);
            PG8_WAIT_L(8); PG8_BAR; PG8_WAIT_L(0); PG8_MMA(0, 0, At, B0); PG8_BAR; PG8_SCHED;
            PG8_LDB(B1, 1, 1); PG8_STAGE(PG8_SB(1, 0), b3, voffB);
            PG8_BAR; PG8_WAIT_L(0); PG8_MMA(0, 1, At, B1); PG8_BAR;
            PG8_LDA(At, 1, 1); PG8_STAGE(PG8_SA(1, 0), a3, voffA);
            PG8_BAR; PG8_WAIT_L(0); PG8_MMA(1, 0, At, B0); PG8_BAR; PG8_SCHED;
            PG8_STAGE(PG8_SB(1, 1), b3 + hstep, voffB);
            PG8_WAIT_V(6); PG8_BAR; PG8_MMA(1, 1, At, B1); PG8_BAR;
            }
        }
        if constexpr (ALIGN_EPI) { if (wr == 0) PG8_BAR; }
        if constexpr (!Epi::AFTER_DRAIN) { E(acc, cur, wr, wc, fr, fq); S.done(cur); }
        if (!has_next) break;
#pragma unroll
        for (int a = 0; a < 2; ++a)
#pragma unroll
            for (int b = 0; b < 2; ++b)
#pragma unroll
                for (int m = 0; m < 4; ++m)
#pragma unroll
                    for (int n = 0; n < 2; ++n) acc[a][b][m][n] = (f32x4){0.f, 0.f, 0.f, 0.f};
        cur = nxt; cA = nA; cB = nB; ++ui;
        if constexpr (ALIGN_EPI) { if (wr == 1) PG8_BAR; }
    }
    PG8_WAIT_V(0);
    if constexpr (!ALIGN_EPI) { if (wr == 0) PG8_BAR; }
    PG8_BAR;
#undef PG8_SA
#undef PG8_SB
#undef PG8_STAGE
#undef PG8_LDA
#undef PG8_LDB
#undef PG8_MMA
#undef PG8_WAIT_V
#undef PG8_WAIT_L
#undef PG8_BAR
#undef PG8_SCHED
}
}

typedef unsigned short bf16;
typedef short bf16x8 __attribute__((ext_vector_type(8)));
typedef short s16x4 __attribute__((ext_vector_type(4)));
typedef float f32x4 __attribute__((ext_vector_type(4)));
typedef float f32x2 __attribute__((ext_vector_type(2)));
typedef float f32x16 __attribute__((ext_vector_type(16)));
typedef unsigned u32x4 __attribute__((ext_vector_type(4)));
typedef unsigned u32x2 __attribute__((ext_vector_type(2)));

__device__ __forceinline__ unsigned f2bf(float f) { unsigned u = __builtin_bit_cast(unsigned, f); return (u + 0x7fffu + ((u >> 16) & 1u)) >> 16; }
__device__ __forceinline__ unsigned pk2(float lo, float hi) { return pg8::cvt_pk_bf16(lo, hi); }
__device__ __forceinline__ float bflo(unsigned w) { return __builtin_bit_cast(float, w << 16); }
__device__ __forceinline__ float bfhi(unsigned w) { return __builtin_bit_cast(float, w & 0xffff0000u); }
__device__ __forceinline__ float bf2f(bf16 h) { return __builtin_bit_cast(float, (unsigned)h << 16); }
__device__ __forceinline__ float wave_sum(float v) {
#pragma unroll
    for (int o = 1; o < 64; o <<= 1) v += __shfl_xor(v, o);
    return v;
}
__device__ __forceinline__ float silu_f(float v) { return v * __builtin_amdgcn_rcpf(1.f + __builtin_amdgcn_exp2f(-1.4426950408889634f * v)); }
__device__ __forceinline__ float hw_sin(float rad) { float r = rad * 0.15915494309189535f; r = r - floorf(r); return __builtin_amdgcn_sinf(r); }
__device__ __forceinline__ float hw_cos(float rad) { float r = rad * 0.15915494309189535f; r = r - floorf(r); return __builtin_amdgcn_cosf(r); }

constexpr int DM = 2048, DIN = 6144, NL = 4;
constexpr int MP = 4096, MROWS = 36864;
constexpr int LP = 256, LS = 4096, SKV_S = 4352;
constexpr float ALPHA = 1.681792830507429f;
constexpr float LN_EPS = 1e-6f;
constexpr int PST = 4096;
constexpr int C_CMU = 0, C_CMV = 512, C_CMG = 1024, C_Q = 1536, C_K = 2560, C_V = 2816, C_ATG = 3072;
constexpr int FLEN_S = 4096 + 128 + 16, FLEN_P = 256 + 64 + 16;
constexpr size_t MiB = 1u << 20;
constexpr size_t WS_MOD = 1 * MiB;
constexpr size_t WS_FS = 2 * MiB;
constexpr size_t WS_FP = 36 * MiB;
constexpr size_t WS_WIN = 40 * MiB;
constexpr size_t WS_WOUT = 136 * MiB;
constexpr size_t WS_H = 168 * MiB;
constexpr size_t WS_P = 312 * MiB;
constexpr size_t WS_ZT = 600 * MiB;
constexpr size_t WS_MIX = 744 * MiB;
constexpr size_t WS_KL = 888 * MiB, WS_VL = 906 * MiB;
constexpr size_t WS_KP = 924 * MiB, WS_VP = 926 * MiB;
constexpr size_t WS_H2 = 928 * MiB;
constexpr size_t WS_STATS = 936 * MiB; static_assert(WS_STATS == ((size_t)936u << 20) && WS_MOD == ((size_t)1u << 20) && WS_P == ((size_t)312u << 20), "EpiResid hard-codes these two offsets");
constexpr size_t WS_YT = 940 * MiB;
constexpr size_t WS_END = 976 * MiB;
constexpr int LDS_BYTES = 163840;


__device__ __forceinline__ void p0_transpose_item(const float* W, int K, int N, bf16* WT, float* scr, int item, int lane) {
    const int nblk = N / 32, kb = item / nblk, nb = item % nblk, k0 = 64 * kb, n0 = 32 * nb;
#pragma unroll 8
    for (int i = 0; i < 32; ++i) { const int kk = 2 * i + (lane >> 5); scr[kk * 33 + (lane & 31)] = W[(size_t)(k0 + kk) * N + n0 + (lane & 31)]; }
    asm volatile("s_waitcnt lgkmcnt(0)" ::: "memory");
    const int c = lane & 7;
#pragma unroll
    for (int j = 0; j < 4; ++j) { const int n = (lane >> 3) + 8 * j; const float* s = scr + (8 * c) * 33 + n;
        u32x4 o; o.x = pk2(s[0 * 33], s[1 * 33]); o.y = pk2(s[2 * 33], s[3 * 33]); o.z = pk2(s[4 * 33], s[5 * 33]); o.w = pk2(s[6 * 33], s[7 * 33]);
        *(u32x4*)(WT + (size_t)(n0 + n) * K + k0 + 8 * c) = o; }
    asm volatile("s_waitcnt lgkmcnt(0)" ::: "memory");
}

__device__ __forceinline__ void phase0(const Args& a, char* lds, int tid, int lane, int wave, int G) {
    const int gw = blockIdx.x * 8 + wave, NGW = G * 8;
    {
        float* h2buf = (float*)(a.ws + WS_H2);
        for (int task = gw; task < NL * 4352; task += NGW) {
            const int l = task / 4352, tt = task % 4352; const int L = tt < 256 ? 256 : 4096; const int pos = tt < 256 ? tt : tt - 256;
            const float* w1 = a.in[11] + l * 33 * 64; const float* b1 = a.in[12] + l * 64; const float* w2 = a.in[13] + l * 64 * 64; const float* b2 = a.in[14] + l * 64;
            const float fr = a.in[16][l * 64 + lane];
            float pre = b1[lane] + ((float)pos / (float)(L - 1)) * w1[lane];
#pragma unroll
            for (int i = 0; i < 16; ++i) {
                const float fb = 1e-4f + (float)i * ((15.0f - 1e-4f) / 15.0f);
                float rev = ((float)pos * fb) / (float)L; rev = rev - floorf(rev);
                const float cs = __builtin_amdgcn_cosf(rev), sn = __builtin_amdgcn_sinf(rev);
                pre += cs * w1[(1 + i) * 64 + lane] - sn * w1[(17 + i) * 64 + lane];
            }
            const float h1 = hw_sin(fr * pre);
            float pre2 = b2[lane];
#pragma unroll 16
            for (int i = 0; i < 64; ++i) pre2 += __shfl(h1, i) * w2[i * 64 + lane];
            h2buf[(size_t)(l * 4352 + tt) * 64 + lane] = hw_sin(fr * pre2);
        }
    }
    {
        float* scr = (float*)(lds + wave * 8448);
        constexpr int I_IN = 32 * 192, I_OUT = 32 * 64;
        for (int it = gw; it < NL * (I_IN + I_OUT); it += NGW) {
            const int l = it / (I_IN + I_OUT); int r = it % (I_IN + I_OUT);
            if (r < I_IN) p0_transpose_item(a.in[8] + (size_t)l * 2048 * 6144, 2048, 6144, (bf16*)(a.ws + WS_WIN) + (size_t)l * 6144 * 2048, scr, r, lane);
            else p0_transpose_item(a.in[24] + (size_t)l * 2048 * 2048, 2048, 2048, (bf16*)(a.ws + WS_WOUT) + (size_t)l * 2048 * 2048, scr, r - I_IN, lane);
        }
    }
    __syncthreads();
    {
        float* sil = (float*)lds;
        float* red = (float*)(lds + 2048 * 12 * 4);
        for (int idx = tid; idx < 9 * 2048; idx += 512) { const int cond = idx >> 11, k = idx & 2047;
            const float v = cond < 8 ? a.in[4][cond * 2048 + k] : a.in[5][k]; sil[k * 12 + cond] = silu_f(v); }
        __syncthreads();
        float* mod = (float*)(a.ws + WS_MOD);
        for (int item = blockIdx.x; item < NL * 96; item += G) {
            const int l = item / 96, n0 = (item % 96) * 64;
            const float* wm = a.in[6] + (size_t)l * 2048 * 6144 + n0 + lane;
            float acc[9];
#pragma unroll
            for (int c = 0; c < 9; ++c) acc[c] = 0.f;
#pragma unroll 8
            for (int kk = 0; kk < 256; ++kk) { const int k = wave * 256 + kk; const float wv = wm[(size_t)k * 6144];
                const f32x4 s0 = *(const f32x4*)(sil + k * 12), s1 = *(const f32x4*)(sil + k * 12 + 4); const float s8 = sil[k * 12 + 8];
                acc[0] += s0[0] * wv; acc[1] += s0[1] * wv; acc[2] += s0[2] * wv; acc[3] += s0[3] * wv;
                acc[4] += s1[0] * wv; acc[5] += s1[1] * wv; acc[6] += s1[2] * wv; acc[7] += s1[3] * wv; acc[8] += s8 * wv; }
#pragma unroll
            for (int c = 0; c < 9; ++c) red[(wave * 9 + c) * 64 + lane] = acc[c];
            __syncthreads();
            for (int idx = tid; idx < 576; idx += 512) { const int c = idx >> 6, ln = idx & 63; float s = a.in[7][l * 6144 + n0 + ln];
#pragma unroll
                for (int w = 0; w < 8; ++w) s += red[(w * 9 + c) * 64 + ln];
                mod[(size_t)(l * 9 + c) * 6144 + n0 + ln] = s; }
            __syncthreads();
        }
    }
}

__device__ __forceinline__ void phase_filt2(const Args& a, char* lds, int tid, int G) {
    const float* h2buf = (const float*)(a.ws + WS_H2);
    float* h2s = (float*)lds;
    for (int item = blockIdx.x; item < NL * 2 * 34; item += G) {
        const int l = item / 68, r = item % 68, order = r / 34, ch = r % 34;
        const bool isS = ch < 32; const int L = isS ? 4096 : 256, P = isS ? 64 : 32, FLEN = isS ? FLEN_S : FLEN_P;
        const int t0 = isS ? ch * 128 : (ch - 32) * 128, ttbase = isS ? 256 : 0;
        const int c = tid;
        bf16* R = (bf16*)(a.ws + (isS ? WS_FS : WS_FP)) + (size_t)((l * 2 + order) * 512 + c) * FLEN;
        __syncthreads();
        for (int idx = tid; idx < 128 * 64; idx += 512) h2s[idx] = h2buf[(size_t)(l * 4352 + ttbase + t0) * 64 + idx];
        float w3r[64];
#pragma unroll
        for (int i = 0; i < 64; ++i) w3r[i] = a.in[15][(size_t)(l * 64 + i) * 1024 + order * 512 + c];
        __syncthreads();
        const float la = -4.605170185988091f / 1.5f, lb = -4.605170185988091f / 0.3f;
        const float delta = fabsf(la + (lb - la) * ((float)c / 511.0f));
        const int OFF = L / 2 + P;
        for (int tl = 0; tl < 128; ++tl) {
            const int t = t0 + tl; float s = 0.f;
#pragma unroll
            for (int i = 0; i < 64; i += 4) { const f32x4 hv = *(const f32x4*)(h2s + tl * 64 + i); s += hv[0] * w3r[i] + hv[1] * w3r[i + 1] + hv[2] * w3r[i + 2] + hv[3] * w3r[i + 3]; }
            const float dist = fabsf((float)(t - L / 2)) / (float)(L / 2);
            const float val = s * __expf(-dist * delta);
            R[OFF - (t - L / 2)] = (bf16)f2bf(val);
        }
        if (t0 == 0) { for (int i = 0; i <= P; ++i) R[i] = 0; for (int i = L + P + 1; i < FLEN; ++i) R[i] = 0; }
    }
    __syncthreads();
}

__device__ __forceinline__ void phase_adaln(const Args& a, int l, int lane, int wave, int G) {
    const int gw = blockIdx.x * 8 + wave, NGW = G * 8;
    float* X = a.out; const bf16* Ub = (const bf16*)a.out; const bf16* Ul = (const bf16*)(a.ws + WS_P);
    bf16* H = (bf16*)(a.ws + WS_H); const float* mod = (const float*)(a.ws + WS_MOD); float* stats = (float*)(a.ws + WS_STATS);
    const bool do_ln = l > 0, write_h = l < NL;
    const float* lg = a.in[25] + (do_ln ? (l - 1) * 2048 : 0); const float* lb = a.in[26] + (do_ln ? (l - 1) * 2048 : 0);
    f32x4 g8[8], b8[8];
#pragma unroll
    for (int j = 0; j < 8; ++j) { const int col = 512 * (j >> 1) + 8 * lane + 4 * (j & 1); g8[j] = do_ln ? *(const f32x4*)(lg + col) : (f32x4){1.f, 1.f, 1.f, 1.f}; b8[j] = do_ln ? *(const f32x4*)(lb + col) : (f32x4){0.f, 0.f, 0.f, 0.f}; }
    const int per = (MROWS / 2 + NGW - 1) / NGW, rp0 = gw * per, rp1 = (rp0 + per < MROWS / 2) ? rp0 + per : MROWS / 2;
    f32x4 sh8[8], sc8[8]; int ccur = -1;
#pragma unroll
    for (int j = 0; j < 8; ++j) { sh8[j] = (f32x4){0.f, 0.f, 0.f, 0.f}; sc8[j] = (f32x4){1.f, 1.f, 1.f, 1.f}; }
    for (int rowp = rp0; rowp < rp1; ++rowp) {
        f32x4 v[2][8]; float s[2] = {0.f, 0.f};
#pragma unroll
        for (int rr = 0; rr < 2; ++rr) { const int row = 2 * rowp + rr;
            if (l > 0) { const bf16* ub = ((l < NL) ? Ub : Ul) + (size_t)row * 2048 + 8 * lane;
#pragma unroll
                for (int j = 0; j < 4; ++j) { const u32x4 w = *(const u32x4*)(ub + 512 * j);
                    v[rr][2 * j] = (f32x4){bflo(w.x), bfhi(w.x), bflo(w.y), bfhi(w.y)}; v[rr][2 * j + 1] = (f32x4){bflo(w.z), bfhi(w.z), bflo(w.w), bfhi(w.w)}; }
            } else { const float* src = (row < MP ? a.in[0] + (size_t)row * 2048 : a.in[1] + (size_t)(row - MP) * 2048) + 8 * lane;
#pragma unroll
                for (int j = 0; j < 4; ++j) { v[rr][2 * j] = *(const f32x4*)(src + 512 * j); v[rr][2 * j + 1] = *(const f32x4*)(src + 512 * j + 4); } } }
#pragma unroll
        for (int rr = 0; rr < 2; ++rr) { const int row = 2 * rowp + rr;
#pragma unroll
        for (int j = 0; j < 8; ++j) s[rr] += (v[rr][j][0] + v[rr][j][1]) + (v[rr][j][2] + v[rr][j][3]);
        if (do_ln) {
            const float mean = wave_sum(s[rr]) * (1.f / 2048.f); float q = 0.f;
#pragma unroll
            for (int j = 0; j < 8; ++j) { v[rr][j] = v[rr][j] - mean; q += (v[rr][j][0] * v[rr][j][0] + v[rr][j][1] * v[rr][j][1]) + (v[rr][j][2] * v[rr][j][2] + v[rr][j][3] * v[rr][j][3]); }
            const float rstd = 1.f / sqrtf(wave_sum(q) * (1.f / 2048.f) + LN_EPS);
            if (write_h && lane == 0) *(f32x2*)(stats + 2 * (size_t)row) = (f32x2){mean, rstd};
#pragma unroll
            for (int j = 0; j < 8; ++j) v[rr][j] = v[rr][j] * rstd * g8[j] + b8[j];
        }
        if (!write_h) {
#pragma unroll
            for (int j = 0; j < 8; ++j) *(f32x4*)(X + (size_t)row * 2048 + 512 * (j >> 1) + 8 * lane + 4 * (j & 1)) = v[rr][j];
        } else {
            const int cond = row < MP ? 8 : ((row - MP) >> 12);
            if (cond != ccur) { ccur = cond; const float* m = mod + (size_t)(l * 9 + cond) * 6144;
#pragma unroll
                for (int j = 0; j < 8; ++j) { const int col = 512 * (j >> 1) + 8 * lane + 4 * (j & 1); sh8[j] = *(const f32x4*)(m + col); sc8[j] = *(const f32x4*)(m + 2048 + col) + 1.f; } }
#pragma unroll
            for (int j = 0; j < 4; ++j) { const int col = 512 * j + 8 * lane;
                const f32x4 h0 = v[rr][2 * j] * sc8[2 * j] + sh8[2 * j], h1 = v[rr][2 * j + 1] * sc8[2 * j + 1] + sh8[2 * j + 1];
                u32x4 w; w.x = pk2(h0[0], h0[1]); w.y = pk2(h0[2], h0[3]); w.z = pk2(h1[0], h1[1]); w.w = pk2(h1[2], h1[3]);
                *(u32x4*)(H + (size_t)row * 2048 + col) = w; }
        }
        }
    }
}

__device__ __forceinline__ void prep_qkv(const Args& a, int l, int lane, int wave, int G) {
    const int gw = blockIdx.x * 8 + wave, NGW = G * 8;
    bf16* P = (bf16*)(a.ws + WS_P);
    bf16* KL = (bf16*)(a.ws + WS_KL); bf16* VL = (bf16*)(a.ws + WS_VL); bf16* KP = (bf16*)(a.ws + WS_KP); bf16* VP = (bf16*)(a.ws + WS_VP);
    float* nck = a.out + (size_t)MROWS * 2048; float* ncv = nck + (size_t)16 * 4 * 256 * 256;
    const int d0 = 8 * (lane & 15), hsub = lane >> 4;
    const f32x4 qg0 = *(const f32x4*)(a.in[22] + l * 128 + d0), qg1 = *(const f32x4*)(a.in[22] + l * 128 + d0 + 4);
    const f32x4 kg0 = *(const f32x4*)(a.in[23] + l * 128 + d0), kg1 = *(const f32x4*)(a.in[23] + l * 128 + d0 + 4);
    const int axis = (lane & 15) >> 3, half = (lane >> 2) & 1, f0 = 8 * (lane & 3);
    float inv[8];
#pragma unroll
    for (int i = 0; i < 8; ++i) inv[i] = exp2f(-(float)(f0 + i) * (13.287712379549449f / 32.f));
    for (int rowp = gw; rowp < MROWS / 2; rowp += NGW) {
        u32x4 rw[2][3], cmv[2];
#pragma unroll
        for (int rr = 0; rr < 2; ++rr) { const bf16* prow = P + (size_t)(2 * rowp + rr) * PST;
            cmv[rr] = *(const u32x4*)(prow + C_CMV + 8 * lane);
#pragma unroll
            for (int j = 0; j < 3; ++j) rw[rr][j] = *(const u32x4*)(prow + C_Q + 512 * j + 8 * lane); }
#pragma unroll
        for (int rr = 0; rr < 2; ++rr) {
        const int row = 2 * rowp + rr;
        {
            const u32x4 w = cmv[rr]; float x[8] = {bflo(w.x), bfhi(w.x), bflo(w.y), bfhi(w.y), bflo(w.z), bfhi(w.z), bflo(w.w), bfhi(w.w)}; float sm = 0.f;
#pragma unroll
            for (int j = 0; j < 8; ++j) sm += x[j];
            const float mean = wave_sum(sm) * (1.f / 512.f); float qq = 0.f;
#pragma unroll
            for (int j = 0; j < 8; ++j) { x[j] -= mean; qq += x[j] * x[j]; }
            const float rstd = 1.f / sqrtf(wave_sum(qq) * (1.f / 512.f) + LN_EPS);
            if (lane == 0) *(f32x2*)((float*)(a.ws + WS_STATS + 512 * 1024) + 2 * (size_t)row) = (f32x2){mean, rstd};
        }
        const bool lat = row >= MP; int b, s; float cs[8], sn[8];
        if (lat) { b = (row - MP) >> 12; s = (row - MP) & 4095; const float pos = (float)(axis ? (s & 63) : (s >> 6));
#pragma unroll
            for (int i = 0; i < 8; ++i) { const float ang = pos * inv[i]; cs[i] = hw_cos(ang); sn[i] = hw_sin(ang); } }
        else { b = row >> 8; s = row & 255;
#pragma unroll
            for (int i = 0; i < 8; ++i) { cs[i] = 1.f; sn[i] = 0.f; } }
        bf16* prow = P + (size_t)row * PST;
#pragma unroll
        for (int j = 0; j < 3; ++j) {
            const int hd = 4 * j + hsub;
            const u32x4 w = rw[rr][j]; float x[8] = {bflo(w.x), bfhi(w.x), bflo(w.y), bfhi(w.y), bflo(w.z), bfhi(w.z), bflo(w.w), bfhi(w.w)};
            float ss = 0.f;
#pragma unroll
            for (int i = 0; i < 8; ++i) ss += x[i] * x[i];
            ss += __shfl_xor(ss, 1); ss += __shfl_xor(ss, 2); ss += __shfl_xor(ss, 4); ss += __shfl_xor(ss, 8);
            const bool normed = hd < 10; const float r = normed ? 1.f / sqrtf(ss * (1.f / 128.f) + LN_EPS) : 1.f;
#pragma unroll
            for (int i = 0; i < 8; ++i) { const float g = !normed ? 1.f : (hd < 8 ? (i < 4 ? qg0[i & 3] : qg1[i & 3]) : (i < 4 ? kg0[i & 3] : kg1[i & 3])); x[i] = x[i] * r * g; }
            float u[8];
#pragma unroll
            for (int i = 0; i < 8; ++i) u[i] = x[i];
#pragma unroll
            for (int i = 0; i < 8; ++i) { const float p = __shfl_xor(x[i], 4);
                const float ro = half == 0 ? (u[i] * cs[i] - p * sn[i]) : (p * sn[i] + u[i] * cs[i]); x[i] = (lat && normed) ? ro : u[i]; }
            u32x4 ow; ow.x = pk2(x[0], x[1]); ow.y = pk2(x[2], x[3]); ow.z = pk2(x[4], x[5]); ow.w = pk2(x[6], x[7]);
            if (j < 2) { *(u32x4*)(prow + C_Q + 512 * j + 8 * lane) = ow; }
            else { const int kv = hsub & 1; const bool isk = hsub < 2;
                if (lat) { bf16* dst = (isk ? KL : VL) + ((size_t)(b * 2 + kv) * SKV_S + s) * 128 + d0; *(u32x4*)dst = ow; }
                else { bf16* dst = (isk ? KP : VP) + ((size_t)(b * 2 + kv) * LP + s) * 128 + d0; *(u32x4*)dst = ow;
                    float* o = (isk ? nck : ncv) + ((size_t)((b * 4 + l) * 256 + s) * 2 + kv) * 128 + d0;
                    *(f32x4*)o = (f32x4){u[0], u[1], u[2], u[3]}; *(f32x4*)(o + 4) = (f32x4){u[4], u[5], u[6], u[7]}; } }
        }
        }
    }
    for (int task = gw; task < 8 * 256 * 2; task += NGW) {
        const int kv = task & 1, j = (task >> 1) & 255, b = task >> 9;
        const size_t so = ((size_t)((b * 4 + l) * 256 + j) * 2 + kv) * 128 + 2 * lane;
        const f32x2 kx = *(const f32x2*)(a.in[2] + so), vx = *(const f32x2*)(a.in[3] + so);
        const size_t d = ((size_t)(b * 2 + kv) * SKV_S + 4096 + j) * 128 + 2 * lane;
        *(unsigned*)(KL + d) = pk2(kx[0], kx[1]); *(unsigned*)(VL + d) = pk2(vx[0], vx[1]);
    }
}

__device__ __forceinline__ void prep_chunkmlp(const Args& a, int l, char* lds, int tid, int lane, int wave, int G) {
    const bf16* P = (const bf16*)(a.ws + WS_P); bf16* MIX = (bf16*)(a.ws + WS_MIX);
    constexpr int VS = 288;
    char* vT = lds;
    const float* lng = a.in[18] + l * 512; const float* lnb = a.in[19] + l * 512;
    const int fr = lane & 15, fq = lane >> 4;
    for (int item = blockIdx.x; item < 288 * 4; item += G) {
        const int ci = item >> 2, hd = item & 3, r0 = ci * 128;
        __syncthreads();
        { const float* st2 = (const float*)(a.ws + WS_STATS + 512 * 1024);
          const int tsub = lane >> 4, chk = lane & 15, ch = 128 * hd + 8 * chk;
          const f32x4 lga = *(const f32x4*)(lng + ch), lgb = *(const f32x4*)(lng + ch + 4), lba = *(const f32x4*)(lnb + ch), lbb = *(const f32x4*)(lnb + ch + 4);
          u32x4 wt[4]; f32x2 sv[4];
#pragma unroll
          for (int i = 0; i < 4; ++i) { const int q = wave * 16 + 4 * i + tsub; wt[i] = *(const u32x4*)(P + (size_t)(r0 + q) * PST + C_CMV + ch); sv[i] = *(const f32x2*)(st2 + 2 * (size_t)(r0 + q)); }
#pragma unroll
          for (int i = 0; i < 4; ++i) { const int q = wave * 16 + 4 * i + tsub; const u32x4 w = wt[i]; const float mean = sv[i][0], rstd = sv[i][1];
              const float x[8] = {bflo(w.x), bfhi(w.x), bflo(w.y), bfhi(w.y), bflo(w.z), bfhi(w.z), bflo(w.w), bfhi(w.w)};
#pragma unroll
              for (int j = 0; j < 8; ++j) { const float gg = j < 4 ? lga[j & 3] : lgb[j & 3], bb = j < 4 ? lba[j & 3] : lbb[j & 3]; const float y = (x[j] - mean) * rstd * gg + bb;
                  *(bf16*)(vT + (8 * chk + j) * VS + q * 2) = (bf16)f2bf(y); } } }
        __syncthreads();
        const float* ws_ = a.in[20] + ((size_t)(l * 4 + hd) * 128 + wave * 16 + fr) * 128 + 8 * fq;
        bf16x8 wf[4];
#pragma unroll
        for (int kb = 0; kb < 4; ++kb) { const f32x4 lo = *(const f32x4*)(ws_ + 32 * kb), hi = *(const f32x4*)(ws_ + 32 * kb + 4);
            u32x4 w; w.x = pk2(lo[0], lo[1]); w.y = pk2(lo[2], lo[3]); w.z = pk2(hi[0], hi[1]); w.w = pk2(hi[2], hi[3]); wf[kb] = __builtin_bit_cast(bf16x8, w); }
        f32x4 acc[8];
#pragma unroll
        for (int ct = 0; ct < 8; ++ct) { acc[ct] = (f32x4){0.f, 0.f, 0.f, 0.f};
#pragma unroll
            for (int kb = 0; kb < 4; ++kb) { const bf16x8 vf = *(const bf16x8*)(vT + (16 * ct + fr) * VS + 64 * kb + 16 * fq);
                acc[ct] = __builtin_amdgcn_mfma_f32_16x16x32_bf16(vf, wf[kb], acc[ct], 0, 0, 0); } }
        const int pl = wave * 16 + fr, row = r0 + pl; const float bs = a.in[21][(l * 4 + hd) * 128 + pl];
        const bf16* prow = P + (size_t)row * PST; bf16* mrow = MIX + (size_t)row * 2048 + 512 + 128 * hd;
#pragma unroll
        for (int ct = 0; ct < 8; ++ct) { const int c4 = 16 * ct + 4 * fq;
            const u32x2 uw = *(const u32x2*)(prow + C_CMU + 128 * hd + c4), gw_ = *(const u32x2*)(prow + C_CMG + 128 * hd + c4);
            const float y0 = bflo(uw.x) * (acc[ct][0] + bs) * silu_f(bflo(gw_.x)), y1 = bfhi(uw.x) * (acc[ct][1] + bs) * silu_f(bfhi(gw_.x));
            const float y2 = bflo(uw.y) * (acc[ct][2] + bs) * silu_f(bflo(gw_.y)), y3 = bfhi(uw.y) * (acc[ct][3] + bs) * silu_f(bfhi(gw_.y));
            u32x2 o; o.x = pk2(y0, y1); o.y = pk2(y2, y3); *(u32x2*)(mrow + c4) = o; }
    }
    __syncthreads();
}

template <int L, int P, int NB, int ABL = 0>
__device__ __forceinline__ void hyena_item(const Args& a, int l, int c, char* lds, int tid, int lane, int wave) {
    constexpr int NT1 = L / P, NT = NB * NT1 / 16, MT = P / 16, KB = P / 32, D1MAX = (L / 2) / P, OFF = L / 2 + P, FLEN = L + 2 * P + 16, SROW = 2 * P + 32;
    constexpr bool FAST = (NB == 1);
    constexpr int ZW = (NB * NT1 + (FAST ? 1 : 0)) * SROW;
    constexpr int FOFF = 8 * ZW;
    constexpr int FB = ((FLEN * 2 + 15) / 16) * 16, CB = 8704;
    constexpr unsigned CPACK = 0x62DB0A62u;
#define HY_COFF(k) ((int)((CPACK >> (4 * (k))) & 15u))
    const bf16* ZT = (const bf16*)(a.ws + WS_ZT); bf16* MIX = (bf16*)(a.ws + WS_MIX);
    const bool isS = (L == 4096);
    const int seq0 = isS ? MP + wave * L : (2 * wave) * L;
    char* zw = lds + wave * ZW;
    const int n16 = lane & 15, q4 = lane >> 4;
    __syncthreads();
    const bf16* Rg = (const bf16*)(a.ws + (isS ? WS_FS : WS_FP));
    if constexpr (!FAST) {
      for (int idx = tid; idx < 2 * (FLEN / 8); idx += 512) { const int o = idx / (FLEN / 8), i = idx % (FLEN / 8);
          *(u32x4*)(lds + FOFF + o * FB + i * 16) = *(const u32x4*)(Rg + (size_t)((l * 2 + o) * 512 + c) * FLEN + i * 8); } }
    const float* cw = a.in[9] + l * 3 * 1536; const float* cb = a.in[10] + l * 1536;
    u32x4 xrA[MT][NT], xrB[MT][NT]; u32x2 grB[MT][NT];
    { const bf16* xg = ZT + (size_t)(512 + c) * MROWS + seq0 + (n16 * P + 4 * q4 - 2);
      const bf16* sg = ZT + (size_t)(1536 + c) * MROWS + seq0 + (n16 * P + 4 * q4);
#pragma unroll
      for (int nt = 0; nt < NT; ++nt)
#pragma unroll
          for (int mt = 0; mt < MT; ++mt) {
              if (!(ABL & 4)) { const unsigned* xa = (const unsigned*)(xg + (16 * nt * P + 16 * mt)); xrA[mt][nt] = (u32x4){xa[0], xa[1], xa[2], xa[3]};
                  const unsigned* xb = (const unsigned*)(xg + (size_t)512 * MROWS + (16 * nt * P + 16 * mt)); xrB[mt][nt] = (u32x4){xb[0], xb[1], xb[2], xb[3]};
                  grB[mt][nt] = *(const u32x2*)(sg + (16 * nt * P + 16 * mt)); }
              else { xrA[mt][nt] = (u32x4){0x3f803f80u, 0x3f803f80u, 0x3f803f80u, 0x3f803f80u}; xrB[mt][nt] = xrA[mt][nt]; grB[mt][nt] = (u32x2){0u, 0u}; } } }
    { const bf16* zr = ZT + (size_t)c * MROWS + seq0; const float w0 = cw[c], w1 = cw[1536 + c], w2 = cw[3072 + c], bb = cb[c];
#pragma unroll
      for (int ci = 0; ci < ((ABL & 16) ? 0 : NB * L / 512); ++ci) { const int ch = lane + 64 * ci; const int t = 8 * ch, tl = t & (L - 1);
          const u32x4 w = *(const u32x4*)(zr + t);
          float xp = bf2f(zr[t - 1]), xn = bf2f(zr[t + 8]);
          xp = tl == 0 ? 0.f : xp; xn = (tl + 8 == L) ? 0.f : xn;
          const float x0 = bflo(w.x), x1 = bfhi(w.x), x2 = bflo(w.y), x3 = bfhi(w.y), x4 = bflo(w.z), x5 = bfhi(w.z), x6 = bflo(w.w), x7 = bfhi(w.w);
          u32x4 o;
          o.x = pk2(xp * w0 + x0 * w1 + x1 * w2 + bb, x0 * w0 + x1 * w1 + x2 * w2 + bb); o.y = pk2(x1 * w0 + x2 * w1 + x3 * w2 + bb, x2 * w0 + x3 * w1 + x4 * w2 + bb);
          o.z = pk2(x3 * w0 + x4 * w1 + x5 * w2 + bb, x4 * w0 + x5 * w1 + x6 * w2 + bb); o.w = pk2(x5 * w0 + x6 * w1 + x7 * w2 + bb, x6 * w0 + x7 * w1 + xn * w2 + bb);
          *(u32x4*)(zw + (t / P) * SROW + (t % P) * 2) = o; }
      if (FAST && lane < SROW / 16) { unsigned z0; asm volatile("v_mov_b32 %0, 0" : "=v"(z0)); *(u32x4*)(zw + NT1 * SROW + 16 * lane) = (u32x4){z0, z0, z0, z0}; } }
    u32x2 gtA[MT][NT], gtB[MT][NT];
#define HY_GATECALC(oo, XR, GT) do { const int gc = 512 * ((oo) + 1) + c; const float gw0 = cw[gc], gw1 = cw[1536 + gc], gw2 = cw[3072 + gc], gbb = cb[gc]; \
        _Pragma("unroll") for (int nt = 0; nt < NT; ++nt) _Pragma("unroll") for (int mt = 0; mt < MT; ++mt) { \
            const int tl = ((16 * nt + n16) * P + 16 * mt + 4 * q4) & (L - 1); const u32x4 xw = XR[mt][nt]; \
            const float xp = tl == 0 ? 0.f : bfhi(xw.x), xn = (tl + 4 == L) ? 0.f : bflo(xw.w); \
            const float r0 = bflo(xw.y), r1 = bfhi(xw.y), r2 = bflo(xw.z), r3 = bfhi(xw.z); \
            float g0 = xp * gw0 + r0 * gw1 + r1 * gw2 + gbb, g1 = r0 * gw0 + r1 * gw1 + r2 * gw2 + gbb, g2 = r1 * gw0 + r2 * gw1 + r3 * gw2 + gbb, g3 = r2 * gw0 + r3 * gw1 + xn * gw2 + gbb; \
            if ((oo) == 1 && !(ABL & 4)) { const u32x2 gv = grB[mt][nt]; g0 *= silu_f(bflo(gv.x)); g1 *= silu_f(bfhi(gv.x)); g2 *= silu_f(bflo(gv.y)); g3 *= silu_f(bfhi(gv.y)); } \
            GT[mt][nt].x = pk2(g0, g1); GT[mt][nt].y = pk2(g2, g3); } } while (0)
    HY_GATECALC(0, xrA, gtA); HY_GATECALC(1, xrB, gtB);
#undef HY_GATECALC
    if constexpr (!FAST) __syncthreads();
#pragma unroll 1
    for (int o = 0; o < 2; ++o) {
        f32x4 acc[MT][NT];
#pragma unroll
        for (int mt = 0; mt < MT; ++mt)
#pragma unroll
            for (int nt = 0; nt < NT; ++nt) acc[mt][nt] = (f32x4){0.f, 0.f, 0.f, 0.f};
        u32x2 gt[MT][NT];
#pragma unroll
        for (int mt = 0; mt < MT; ++mt)
#pragma unroll
            for (int nt = 0; nt < NT; ++nt) { gt[mt][nt].x = o ? gtB[mt][nt].x : gtA[mt][nt].x; gt[mt][nt].y = o ? gtB[mt][nt].y : gtA[mt][nt].y; }
        if constexpr (FAST) {
            if (o) __syncthreads();
            { const unsigned* Rd = (const unsigned*)(Rg + (size_t)((l * 2 + o) * 512 + c) * FLEN); constexpr int ND = FLEN / 2;
#pragma unroll
              for (int mi = 0; mi < ((ABL & 8) ? 0 : (ND + 511) / 512); ++mi) { const int m = tid + 512 * mi; unsigned d[5];
                  if (m < ND) {
#pragma unroll
                  for (int i = 0; i < 5; ++i) d[i] = (m + i < ND) ? Rd[m + i] : 0u;
#pragma unroll
                  for (int k = 0; k < 8; ++k) { const unsigned v = (k & 1) ? __builtin_amdgcn_alignbit(d[(k + 1) / 2], d[(k - 1) / 2], 16u) : d[k / 2];
                      *(unsigned*)(lds + FOFF + k * CB + 16 * HY_COFF(k) + 4 * m) = v; } } } }
            __syncthreads();
            const int kk = (OFF - n16) & 7;
            const int abase = FOFF + kk * CB + 16 * HY_COFF(kk) + 2 * (OFF - n16 + 8 * q4 - kk) - 96;
            const int bbase = wave * ZW + n16 * SROW + 16 * q4;
            const int zrow = wave * ZW + NT1 * SROW + 16 * q4;
            static_assert(NT == 4 && NT1 == 64 && D1MAX == 32 && MT == 4 && KB == 2, "r-major loop below is for the latent shape");
#define HY_ALOAD(K_, A0_) do { _Pragma("unroll") for (int mt = 0; mt < 4; ++mt) A0_[mt] = *(const bf16x8*)(lds + ar + (2048 * (1 - (K_)) + 32 * (3 - mt))); } while (0)
#define HY_KMMA(K_, A0_) do { bf16x8 a1[4]; \
                _Pragma("unroll") for (int mt = 0; mt < 2; ++mt) a1[mt] = *(const bf16x8*)(lds + ar + (2048 * (1 - (K_)) + 64 + 32 * (3 - mt))); \
                a1[2] = A0_[0]; a1[3] = A0_[1]; \
                __builtin_amdgcn_s_setprio(1); \
                _Pragma("unroll") for (int nn = 0; nn < 4; ++nn) { const int nt = 3 - nn, j = nt - (K_); if (j < 0 || j > 4) continue; \
                    _Pragma("unroll") for (int mt = 0; mt < 4; ++mt) acc[mt][nt] = __builtin_amdgcn_mfma_f32_16x16x32_bf16(A0_[mt], bt[j][0], acc[mt][nt], 0, 0, 0); } \
                _Pragma("unroll") for (int nn = 0; nn < 4; ++nn) { const int nt = 3 - nn, j = nt - (K_); if (j < 0 || j > 4) continue; \
                    _Pragma("unroll") for (int mt = 0; mt < 4; ++mt) acc[mt][nt] = __builtin_amdgcn_mfma_f32_16x16x32_bf16(a1[mt], bt[j][1], acc[mt][nt], 0, 0, 0); } \
                __builtin_amdgcn_s_setprio(0); } while (0)
#define HY_BT(J_) do { const bool ok = (unsigned)(16 * (J_) + n16 - r) < (unsigned)NT1; const int ad = ok ? (bbase - r * SROW) : (zrow - 16 * SROW * (J_)); \
                bt[J_][0] = *(const bf16x8*)(lds + ad + (16 * SROW * (J_))); bt[J_][1] = *(const bf16x8*)(lds + ad + (16 * SROW * (J_) + 64)); } while (0)
#pragma unroll 1
            for (int r = 0; r < ((ABL & 2) ? 1 : 16); ++r) {
                bf16x8 bt[5][2], pa0[4], qa0[4];
                HY_BT(1); HY_BT(2); HY_BT(3); HY_BT(4);
                const int ar = abase - 128 * r - 2048;
                HY_ALOAD(-2, pa0);
                HY_ALOAD(-1, qa0); HY_KMMA(-2, pa0);
                HY_ALOAD(0, pa0);  HY_KMMA(-1, qa0);
                HY_BT(0); HY_ALOAD(1, qa0); HY_KMMA(0, pa0);
                HY_KMMA(1, qa0);
            }
            {
                const int r = 0; bf16x8 bt[5][2], pa0[4];
                HY_BT(0); HY_BT(1);
                bt[2][0] = bt[0][0]; bt[2][1] = bt[0][1]; bt[3][0] = bt[0][0]; bt[3][1] = bt[0][1]; bt[4][0] = bt[0][0]; bt[4][1] = bt[0][1];
                const int ar = abase - 2048;
                if (!(ABL & 2)) { HY_ALOAD(2, pa0); HY_KMMA(2, pa0); }
            }
#undef HY_BT
#undef HY_ALOAD
#undef HY_KMMA
        } else {
        const char* Rl = lds + FOFF + o * FB;
#pragma unroll 1
        for (int d1 = -D1MAX; d1 <= D1MAX; ++d1) {
#pragma unroll
            for (int kb = 0; kb < KB; ++kb) {
                bf16x8 af[MT], bfr[NT];
#pragma unroll
                for (int mt = 0; mt < MT; ++mt) { const int i0 = OFF - P * d1 - 16 * mt - n16 + 32 * kb + 8 * q4; const unsigned sh = (unsigned)(i0 & 1) * 16u;
                    const unsigned* rp = (const unsigned*)(Rl + (i0 >> 1) * 4);
                    const unsigned d0 = rp[0], dd1 = rp[1], d2 = rp[2], d3 = rp[3], d4 = rp[4];
                    u32x4 w; w.x = __builtin_amdgcn_alignbit(dd1, d0, sh); w.y = __builtin_amdgcn_alignbit(d2, dd1, sh); w.z = __builtin_amdgcn_alignbit(d3, d2, sh); w.w = __builtin_amdgcn_alignbit(d4, d3, sh);
                    af[mt] = __builtin_bit_cast(bf16x8, w); }
#pragma unroll
                for (int nt = 0; nt < NT; ++nt) { const int N = 16 * nt + n16, bl = N / NT1, t1 = N % NT1, s1 = t1 - d1; const bool ok = (unsigned)s1 < (unsigned)NT1;
                    u32x4 w = *(const u32x4*)(zw + (bl * NT1 + (ok ? s1 : 0)) * SROW + 64 * kb + 16 * q4);
                    if (!ok) w = (u32x4){0u, 0u, 0u, 0u};
                    bfr[nt] = __builtin_bit_cast(bf16x8, w); }
#pragma unroll
                for (int nt = 0; nt < NT; ++nt) {
#pragma unroll
                    for (int mt = 0; mt < MT; ++mt) acc[mt][nt] = __builtin_amdgcn_mfma_f32_16x16x32_bf16(af[mt], bfr[nt], acc[mt][nt], 0, 0, 0);
                }
            }
        }
        }
        const float skip = a.in[17][(l * 2 + o) * 512 + c];
        bf16* mp = (bf16*)(a.ws + WS_YT) + (size_t)c * MROWS + seq0;
        long to = n16 * P + 4 * q4;
        int zo = n16 * SROW + 8 * q4;
#pragma unroll
        for (int nt = 0; nt < NT; ++nt) {
#pragma unroll
            for (int mt = 0; mt < MT; ++mt) {
                char* zp = zw + zo + 32 * mt; const long t0 = to + 16 * mt;
                const u32x2 zv = *(const u32x2*)zp; const u32x2 gg = gt[mt][nt];
                const float y0 = bflo(gg.x) * (acc[mt][nt][0] + skip * bflo(zv.x)), y1 = bfhi(gg.x) * (acc[mt][nt][1] + skip * bfhi(zv.x));
                const float y2 = bflo(gg.y) * (acc[mt][nt][2] + skip * bflo(zv.y)), y3 = bfhi(gg.y) * (acc[mt][nt][3] + skip * bfhi(zv.y));
                if (o == 0) { u32x2 w; w.x = pk2(y0, y1); w.y = pk2(y2, y3); *(u32x2*)zp = w; }
                else if (ABL & 1) { if (y0 + y1 + y2 + y3 == 123.456f) mp[0] = 0; }
                else { u32x2 w; w.x = pk2(y0, y1); w.y = pk2(y2, y3); *(u32x2*)(mp + t0) = w; } }
            to += 16 * P; zo += 16 * SROW;
            asm volatile("" : "+v"(to), "+v"(zo)); }
    }
    __syncthreads();
}

namespace attn {
constexpr int D = 128, NW = 8, QBLK = 32, KVBLK = 64;
constexpr float SCALE = 0.088388347648318440f;
constexpr float THR = 8.f;
constexpr int LDQ = 4096, LDK = 128;
constexpr size_t SHM_V = KVBLK * D * 2, SHM_K = KVBLK * D * 2;
#define KSWZ(row, colB) ((row) * 256 + ((colB) ^ (((row) & 7) << 4)))
#define SBAR() __builtin_amdgcn_sched_barrier(0)
__device__ __forceinline__ int crow(int r, int hi) { return (r & 3) + 8 * (r >> 2) + 4 * hi; }
__device__ __forceinline__ unsigned cvtpk(float lo, float hi) { unsigned r; asm volatile("v_cvt_pk_bf16_f32 %0, %1, %2" : "=v"(r) : "v"(lo), "v"(hi)); return r; }
__device__ __forceinline__ void partialSM(f32x16& p0, f32x16& p1, float& m_reg, float& mn, float& alpha) {
  constexpr float C = SCALE * 1.4426950408889634f;
  float pmax = p0[0]; for (int r = 1; r < 16; ++r) pmax = fmaxf(pmax, p0[r]); for (int r = 0; r < 16; ++r) pmax = fmaxf(pmax, p1[r]);
  { auto rr = __builtin_amdgcn_permlane32_swap(__float_as_uint(pmax), __float_as_uint(pmax), false, false);
    pmax = fmaxf(__uint_as_float(rr[0]), __uint_as_float(rr[1])); }
  if (__builtin_expect(__all(pmax - m_reg <= THR / SCALE), 1)) { mn = m_reg; alpha = 1.f; }
  else { mn = fmaxf(m_reg, pmax); alpha = __builtin_amdgcn_exp2f((m_reg - mn) * C); m_reg = mn; }
  float mnC = -mn * C;
  for (int r = 0; r < 16; ++r) p0[r] = fmaf(p0[r], C, mnC); for (int r = 0; r < 16; ++r) p1[r] = fmaf(p1[r], C, mnC);
  for (int r = 0; r < 16; ++r) p0[r] = __builtin_amdgcn_exp2f(p0[r]);
}
__device__ __forceinline__ void finishSM(f32x16& p0, f32x16& p1, float alpha, float& l_reg, bf16x8& pa0, bf16x8& pa1, bf16x8& pa2, bf16x8& pa3) {
  for (int r = 0; r < 16; ++r) p1[r] = __builtin_amdgcn_exp2f(p1[r]);
  float ps = 0; for (int r = 0; r < 16; ++r) ps += p0[r]; for (int r = 0; r < 16; ++r) ps += p1[r];
  { auto rr = __builtin_amdgcn_permlane32_swap(__float_as_uint(ps), __float_as_uint(ps), false, false);
    ps = __uint_as_float(rr[0]) + __uint_as_float(rr[1]); }
  l_reg = l_reg * alpha + ps;
#define PK4(Pv, BASE, OUT) do { unsigned a0 = cvtpk(Pv[BASE + 0], Pv[BASE + 1]), a1 = cvtpk(Pv[BASE + 2], Pv[BASE + 3]);   \
    unsigned b0 = cvtpk(Pv[BASE + 4], Pv[BASE + 5]), b1 = cvtpk(Pv[BASE + 6], Pv[BASE + 7]);                              \
    auto r0 = __builtin_amdgcn_permlane32_swap(a0, b0, false, false); auto r1 = __builtin_amdgcn_permlane32_swap(a1, b1, false, false); \
    u32x4 w = {r0[0], r1[0], r0[1], r1[1]}; OUT = *reinterpret_cast<bf16x8*>(&w); } while (0)
  PK4(p0, 0, pa0); PK4(p0, 8, pa1); PK4(p1, 0, pa2); PK4(p1, 8, pa3);
#undef PK4
}
__device__ __forceinline__ void qkt(f32x16& p0, f32x16& p1, const bf16* Ks, const bf16x8* qr, int r32, int hi) {
  p0 = f32x16{}; p1 = f32x16{};
  for (int d0 = 0; d0 < 8; ++d0) { int cb = (d0 * 16 + hi * 8) * 2;
    bf16x8 b0 = *reinterpret_cast<const bf16x8*>((const char*)Ks + KSWZ(r32, cb));
    bf16x8 b1 = *reinterpret_cast<const bf16x8*>((const char*)Ks + KSWZ(32 + r32, cb));
    p0 = __builtin_amdgcn_mfma_f32_32x32x16_bf16(b0, qr[d0], p0, 0, 0, 0);
    p1 = __builtin_amdgcn_mfma_f32_32x32x16_bf16(b1, qr[d0], p1, 0, 0, 0); }
}
__device__ __forceinline__ int v_st(int k, int c) { const int kk = (k & ~0xC) | ((k & 4) << 1) | ((k & 8) >> 1); return ((kk >> 3) * 4 + (c >> 5)) * 512 + ((kk & 7) * 32 + (c & 31)) * 2; }
__device__ __forceinline__ int v_rd_base(int lane) { return ((lane & 3) << 3) | (((lane >> 2) & 3) << 6) | (((lane >> 4) & 1) << 5) | (((lane >> 5) & 1) << 8); }
constexpr int v_rd_off(int d0, int ks, int half) { return d0 * 512 + ks * 4096 + half * 2048; }
template <int OFFS> __device__ __forceinline__ s16x4 tr_read(int vb) {
  s16x4 r; asm volatile("ds_read_b64_tr_b16 %0, %1 offset:%2" : "=&v"(r) : "v"(vb), "i"(OFFS) : "memory"); return r;
}
template <int D0> __device__ __forceinline__ void pv_one(f32x16& od, int vb, bf16x8 pa0, bf16x8 pa1, bf16x8 pa2, bf16x8 pa3) {
  const s16x4 l0 = tr_read<v_rd_off(D0, 0, 0)>(vb), h0 = tr_read<v_rd_off(D0, 0, 1)>(vb), l1 = tr_read<v_rd_off(D0, 1, 0)>(vb), h1 = tr_read<v_rd_off(D0, 1, 1)>(vb);
  const s16x4 l2 = tr_read<v_rd_off(D0, 2, 0)>(vb), h2 = tr_read<v_rd_off(D0, 2, 1)>(vb), l3 = tr_read<v_rd_off(D0, 3, 0)>(vb), h3 = tr_read<v_rd_off(D0, 3, 1)>(vb);
  asm volatile("s_waitcnt lgkmcnt(0)" ::: "memory"); SBAR();
#define PK(Lx, Hx) (bf16x8){Lx[0], Lx[1], Lx[2], Lx[3], Hx[0], Hx[1], Hx[2], Hx[3]}
  od = __builtin_amdgcn_mfma_f32_32x32x16_bf16(pa0, PK(l0, h0), od, 0, 0, 0);
  od = __builtin_amdgcn_mfma_f32_32x32x16_bf16(pa1, PK(l1, h1), od, 0, 0, 0);
  od = __builtin_amdgcn_mfma_f32_32x32x16_bf16(pa2, PK(l2, h2), od, 0, 0, 0);
  od = __builtin_amdgcn_mfma_f32_32x32x16_bf16(pa3, PK(l3, h3), od, 0, 0, 0);
#undef PK
}
__device__ __forceinline__ void pv_d0(f32x16* o, int vb, bf16x8 pa0, bf16x8 pa1, bf16x8 pa2, bf16x8 pa3) {
  pv_one<0>(o[0], vb, pa0, pa1, pa2, pa3); pv_one<1>(o[1], vb, pa0, pa1, pa2, pa3); pv_one<2>(o[2], vb, pa0, pa1, pa2, pa3); pv_one<3>(o[3], vb, pa0, pa1, pa2, pa3);
}
__device__ __forceinline__ void attn_unit(const bf16* __restrict__ Qb, const bf16* __restrict__ Kh, const bf16* __restrict__ Vh,
                                          const bf16* __restrict__ Gb, bf16* __restrict__ Ob, int seq, char* lds, const int tid) {
  const int wid = tid >> 6, lane = tid & 63, r32 = lane & 31, hi = lane >> 5;
  bf16* V_lds = (bf16*)lds; bf16* K_lds = (bf16*)(lds + 2 * SHM_V);
  float* ws = (float*)(lds + 2 * SHM_V + 2 * SHM_K) + wid * 64; float* li_l = ws; float* al_l = ws + 32;
  float m_reg = -1e30f, l_reg = 0; f32x16 o[4] = {}; bf16x8 qr[8];
  const bf16* Qw = Qb + (long)(wid * QBLK + r32) * LDQ + hi * 8;
#pragma unroll
  for (int d0 = 0; d0 < 8; ++d0) qr[d0] = *reinterpret_cast<const bf16x8*>(Qw + d0 * 16);
  const int sr = tid >> 4, sc = (tid & 15) * 8, vst0 = v_st(sr, sc), vst1 = v_st(32 + sr, sc);
  const int vb0 = (int)(uintptr_t)V_lds + v_rd_base(lane);
  struct { bf16x8 vs0, vs1, ks0, ks1; } sr_[2];
#define SLOAD(i, k0) do { sr_[i].vs0 = *(const bf16x8*)(&Vh[(long)((k0) + sr) * LDK + sc]); sr_[i].vs1 = *(const bf16x8*)(&Vh[(long)((k0) + 32 + sr) * LDK + sc]); \
    sr_[i].ks0 = *(const bf16x8*)(&Kh[(long)((k0) + sr) * LDK + sc]); sr_[i].ks1 = *(const bf16x8*)(&Kh[(long)((k0) + 32 + sr) * LDK + sc]); } while (0)
#define SWRITE(b, i) do { *(bf16x8*)((char*)V_lds + (b) * SHM_V + vst0) = sr_[i].vs0;          \
    *(bf16x8*)((char*)V_lds + (b) * SHM_V + vst1) = sr_[i].vs1; int kc = sc * 2;               \
    *(bf16x8*)((char*)K_lds + (b) * SHM_K + KSWZ(sr, kc)) = sr_[i].ks0;                       \
    *(bf16x8*)((char*)K_lds + (b) * SHM_K + KSWZ(32 + sr, kc)) = sr_[i].ks1; } while (0)
#define SWAIT() asm volatile("s_waitcnt vmcnt(4)" ::: "memory")
#define RESC(av) do { if (__any((av) < 1.f)) { if (hi == 0) al_l[r32] = (av); asm volatile("s_waitcnt lgkmcnt(0)" ::: "memory"); \
    for (int d = 0; d < 4; ++d) for (int r = 0; r < 16; ++r) o[d][r] *= al_l[crow(r, hi)]; } } while (0)
  f32x16 pA0, pA1, pB0, pB1; float mnA, mnB, alA, alB; bf16x8 pa0, pa1, pa2, pa3; const int NT = seq / KVBLK;
  constexpr int SE = 0, SO = 1;
  SLOAD(SE, 0); asm volatile("s_waitcnt vmcnt(0)" ::: "memory"); SWRITE(0, SE); __syncthreads();
  qkt(pA0, pA1, K_lds, qr, r32, hi); partialSM(pA0, pA1, m_reg, mnA, alA);
  SLOAD(SO, KVBLK); if (2 < NT) SLOAD(SE, 2 * KVBLK);
  SWAIT(); SWRITE(1, SO); __syncthreads();
  for (int j = 1; j + 1 < NT; j += 2) {
    SBAR(); qkt(pB0, pB1, (bf16*)((char*)K_lds + SHM_K), qr, r32, hi);
    finishSM(pA0, pA1, alA, l_reg, pa0, pa1, pa2, pa3); SBAR();
    SLOAD(SO, (j + 2) * KVBLK); SBAR();
    pv_d0(o, vb0, pa0, pa1, pa2, pa3); partialSM(pB0, pB1, m_reg, mnB, alB);
    __syncthreads(); SWAIT(); SWRITE(0, SE);
    RESC(alB); __syncthreads();
    SBAR(); qkt(pA0, pA1, K_lds, qr, r32, hi);
    finishSM(pB0, pB1, alB, l_reg, pa0, pa1, pa2, pa3); SBAR();
    if (j + 3 < NT) SLOAD(SE, (j + 3) * KVBLK); SBAR();
    pv_d0(o, vb0 + (int)SHM_V, pa0, pa1, pa2, pa3); partialSM(pA0, pA1, m_reg, mnA, alA);
    __syncthreads(); SWAIT(); SWRITE(1, SO);
    RESC(alA); __syncthreads();
  }
  SBAR(); qkt(pB0, pB1, (bf16*)((char*)K_lds + SHM_K), qr, r32, hi);
  finishSM(pA0, pA1, alA, l_reg, pa0, pa1, pa2, pa3); SBAR();
  pv_d0(o, vb0, pa0, pa1, pa2, pa3); partialSM(pB0, pB1, m_reg, mnB, alB);
  __syncthreads(); RESC(alB);
  finishSM(pB0, pB1, alB, l_reg, pa0, pa1, pa2, pa3); SBAR();
  pv_d0(o, vb0 + (int)SHM_V, pa0, pa1, pa2, pa3);
  if (hi == 0) li_l[r32] = l_reg; asm volatile("s_waitcnt lgkmcnt(0)" ::: "memory"); SBAR();
  float rli[16];
#pragma unroll
  for (int r = 0; r < 16; ++r) rli[r] = __builtin_amdgcn_rcpf(li_l[crow(r, hi)]);
  long go = (long)(wid * QBLK + 4 * hi) * LDQ + r32, oo = (long)(wid * QBLK + 4 * hi) * 2048 + r32;
#pragma unroll
  for (int r = 0; r < 16; ++r) {
#pragma unroll
    for (int d0 = 0; d0 < 4; ++d0) { const float g = bf2f(Gb[go + d0 * 32]); Ob[oo + d0 * 32] = (bf16)f2bf(o[d0][r] * rli[r] * silu_f(g)); }
    const int step = ((r & 3) == 3) ? 5 : 1; go += step * LDQ; oo += step * 2048;
    asm volatile("" : "+v"(go), "+v"(oo) :: "memory"); }
  __syncthreads();
#undef SLOAD
#undef SWRITE
#undef SWAIT
#undef RESC
}
}

__device__ __forceinline__ void phase_ytr(const Args& a, char* lds, int tid, int G) {
    const bf16* YT = (const bf16*)(a.ws + WS_YT); bf16* MIX = (bf16*)(a.ws + WS_MIX);
    constexpr int TS = 144;
    for (int item = blockIdx.x; item < 576 * 2; item += G) {
        const int rt = item >> 1, ct = item & 1, r0 = rt * 64, c0 = ct * 256;
        __syncthreads();
        { const int ch = tid >> 3, part = tid & 7; u32x4 w[4];
#pragma unroll
          for (int i = 0; i < 4; ++i) w[i] = *(const u32x4*)(YT + (size_t)(c0 + ch + 64 * i) * MROWS + r0 + 8 * part);
#pragma unroll
          for (int i = 0; i < 4; ++i) *(u32x4*)(lds + (ch + 64 * i) * TS + ((part ^ ((ch >> 3) & 7)) * 16)) = w[i]; }
        __syncthreads();
#pragma unroll
        for (int i = 0; i < 4; ++i) { const int id = tid + 512 * i, r = id >> 5, cp = id & 31; unsigned short v[8];
#pragma unroll
          for (int j = 0; j < 8; ++j) v[j] = *(const unsigned short*)(lds + (8 * cp + j) * TS + ((((r >> 3) ^ (cp & 7)) * 16) + (r & 7) * 2));
          u32x4 w; w.x = v[0] | ((unsigned)v[1] << 16); w.y = v[2] | ((unsigned)v[3] << 16); w.z = v[4] | ((unsigned)v[5] << 16); w.w = v[6] | ((unsigned)v[7] << 16);
          *(u32x4*)(MIX + (size_t)(r0 + r) * 2048 + c0 + 8 * cp) = w; }
    }
    __syncthreads();
}

template <int SEL> __device__ __forceinline__ void phase_mix(const Args& a, int l, char* lds, int tid_in, int G) {
    const bf16* P = (const bf16*)(a.ws + WS_P); bf16* MIX = (bf16*)(a.ws + WS_MIX);
    const bf16* KL = (const bf16*)(a.ws + WS_KL); const bf16* VL = (const bf16*)(a.ws + WS_VL); const bf16* KP = (const bf16*)(a.ws + WS_KP); const bf16* VP = (const bf16*)(a.ws + WS_VP);
    constexpr int N_HS = 512, N_AS = 1024, N_HP = 512, N_AP = 128, N_ALL = N_HS + N_AS + N_HP + N_AP;
    const int nround = (N_ALL + G - 1) / G; const bool swp = (SEL == 0xF) && (G == 256);
    for (int kr = 0; kr < nround; ++kr) {
        const int kk = (swp && kr < 4) ? ((kr + (int)(blockIdx.x & 3)) & 3) : kr; const int item = blockIdx.x + kk * G; if (item >= N_ALL) continue;
        int r = item;
        int tid = tid_in; asm volatile("" : "+v"(tid));
        const int lane = tid & 63, wave = __builtin_amdgcn_readfirstlane(tid >> 6);
#define HY_CH(r) ((((r) & 7) << 5) | (((r) >> 3) & 31) | ((r) & 256))
        if (r < N_HS) { if ((PMASK & 256) && (SEL & 1)) hyena_item<4096, 64, 1, (SEL == 1 ? HYABL : 0)>(a, l, HY_CH(r), lds, tid, lane, wave); continue; } r -= N_HS;
        if (r < N_AS + N_HP) {
            if (r >= N_AS) { if ((PMASK & 1024) && (SEL & 4)) hyena_item<256, 32, 2>(a, l, HY_CH(r - N_AS), lds, tid, lane, wave); continue; } }
        else r -= N_HP;
        if ((PMASK & 512) && (r < N_AS ? (SEL & 2) : (SEL & 8))) {
            const bool lat = r < N_AS; const int rp = r - N_AS;
            const int h = lat ? (r >> 4) & 7 : (rp & 7), b = lat ? (r >> 7) : (rp >> 3), kvh = h >> 2;
            const size_t row0 = lat ? (size_t)MP + b * 4096 + (r & 15) * 256 : (size_t)b * 256;
            const int seq = lat ? SKV_S : LP;
            const bf16* Kb = (lat ? KL : KP) + (size_t)(b * 2 + kvh) * seq * 128; const bf16* Vb = (lat ? VL : VP) + (size_t)(b * 2 + kvh) * seq * 128;
            attn::attn_unit(P + row0 * PST + C_Q + h * 128, Kb, Vb, P + row0 * PST + C_ATG + h * 128, MIX + row0 * 2048 + 1024 + h * 128, seq, lds, tid);
        }
    }
    __syncthreads();
}


#define LAS __attribute__((address_space(3)))
#define XB_TMO      128
#define XB_XCNT(j)  (256  + 64 * (j))
#define XB_XSUB(j)  (1280 + 64 * (j))
#define XB_XGEN(j)  (2304 + 64 * (j))
#define XB_TOP      3328
#define XB_TOPGEN   3392
#define XCD_BAR_WORDS 3456
#define XB_SPIN_CAP (1u << 22)
__device__ __forceinline__ unsigned xb_ld(unsigned* p)              { return __hip_atomic_load(p, __ATOMIC_RELAXED, __HIP_MEMORY_SCOPE_AGENT); }
__device__ __forceinline__ unsigned xb_add(unsigned* p, unsigned v) { return __hip_atomic_fetch_add(p, v, __ATOMIC_RELAXED, __HIP_MEMORY_SCOPE_AGENT); }
__device__ __forceinline__ unsigned xb_xcc_id() { return (unsigned)__builtin_amdgcn_s_getreg((3 << 11) | 20) & 0xFu; }
#define XB_SPIN(cond, bar) do { unsigned _sp = 0; while (cond) { __builtin_amdgcn_s_sleep(1); \
    if ((++_sp & 255u) == 0u) { if (xb_ld(&(bar)[XB_TMO])) break; if (_sp > XB_SPIN_CAP) { atomicAdd(&(bar)[XB_TMO], 1u); break; } } } } while (0)
struct XcdBarrier { unsigned* bar; unsigned x; volatile LAS unsigned* st; };
__device__ __forceinline__ XcdBarrier xcd_barrier_post(unsigned* bar, volatile LAS unsigned* st) {
    XcdBarrier b; b.bar = bar; b.x = xb_xcc_id(); b.st = st;
    if (threadIdx.x == 0) (void)xb_add(&bar[XB_XCNT(b.x)], 1u);
    return b;
}
__device__ __forceinline__ void xcd_barrier_complete(unsigned* bar, unsigned x, unsigned& nloc, unsigned& nx) {
    const unsigned G = gridDim.x * gridDim.y * gridDim.z;
    unsigned sum, cnt, mine, sp = 0u;
    for (;;) {
        sum = 0u; cnt = 0u; mine = 0u;
#pragma unroll
        for (unsigned j = 0; j < 16; ++j) { const unsigned c = xb_ld(&bar[XB_XCNT(j)]); sum += c; cnt += (c > 0u) ? 1u : 0u; mine = (j == x) ? c : mine; }
        if (sum == G) break;
        __builtin_amdgcn_s_sleep(1);
        if ((++sp & 255u) == 0u) { if (xb_ld(&bar[XB_TMO])) break; if (sp > XB_SPIN_CAP) { atomicAdd(&bar[XB_TMO], 1u); break; } }
    }
    nloc = mine > 0u ? mine : 1u; nx = cnt > 0u ? cnt : 1u;
}
__device__ __forceinline__ void xcd_barrier(const XcdBarrier& b) {
    asm volatile("s_waitcnt vmcnt(0)" ::: "memory");
    __syncthreads();
    if (threadIdx.x == 0) {
        unsigned* bar = b.bar;
        __builtin_amdgcn_s_waitcnt(0);
        unsigned nloc = b.st[0], nx = b.st[1];
        if (nloc == 0u) { xcd_barrier_complete(bar, b.x, nloc, nx); b.st[0] = nloc; b.st[1] = nx; }
        const unsigned old = xb_add(&bar[XB_XSUB(b.x)], 1u);
        const unsigned gen = old / nloc;
        if (old + 1u == (gen + 1u) * nloc) {
            __builtin_amdgcn_fence(__ATOMIC_RELEASE, "agent");
            asm volatile("s_waitcnt vmcnt(0)" ::: "memory");
            const unsigned og = xb_add(&bar[XB_TOP], 1u);
            const unsigned tg = og / nx;
            if (og + 1u == (tg + 1u) * nx) xb_add(&bar[XB_TOPGEN], 1u);
            else XB_SPIN(xb_ld(&bar[XB_TOPGEN]) == tg, bar);
            __builtin_amdgcn_fence(__ATOMIC_ACQUIRE, "agent");
            xb_add(&bar[XB_XGEN(b.x)], 1u);
            asm volatile("s_waitcnt vmcnt(0)" ::: "memory");
        } else {
            XB_SPIN(xb_ld(&bar[XB_XGEN(b.x)]) == gen, bar);
            __builtin_amdgcn_fence(__ATOMIC_ACQUIRE, "agent");
            asm volatile("s_waitcnt vmcnt(0)" ::: "memory");
        }
    }
    __syncthreads();
}

constexpr int N_PHASES = 2 + 6 * NL;
__global__ void __launch_bounds__(512) fwd_megakernel(Args args_unused) {
    extern __shared__ __attribute__((aligned(16))) unsigned char lds_raw[];
    char* lds = (char*)lds_raw;
    const int G = gridDim.x;
    int lo, hi; unsigned* barw; { const Args a0 = load_args(); lo = a0.ph_lo; hi = a0.ph_hi; barw = (unsigned*)a0.ws; }
    volatile LAS unsigned* bst = (volatile LAS unsigned*)((LAS unsigned char*)lds_raw + (LDS_BYTES - 64));
    if (threadIdx.x < 16) bst[threadIdx.x] = 0u;
    __syncthreads();
    XcdBarrier xbar; xbar.bar = barw; xbar.x = 0; xbar.st = bst;
    if (hi - lo > 1) xbar = xcd_barrier_post(barw, bst);
    int ph = 0;
#define RUN(...) do { if (lo <= ph && ph < hi) { int tid = threadIdx.x; asm volatile("" : "+v"(tid)); const int lane = tid & 63, wave = __builtin_amdgcn_readfirstlane(tid >> 6); \
        const Args args = load_args(); (void)lane; (void)wave; __VA_ARGS__; \
        if (ph + 1 < hi) { if (hi == 0x7ffffff0) { asm volatile("s_waitcnt vmcnt(0)" ::: "memory"); __syncthreads(); cg::this_grid().sync(); } else xcd_barrier(xbar); } } ++ph; } while (0)
#define PM(b, ...) do { if (PMASK & (1 << b)) { __VA_ARGS__; } } while (0)
    RUN({ PM(0, phase0(args, lds, tid, lane, wave, G)); if (DUP & 16) { __syncthreads(); phase0(args, lds, tid, lane, wave, G); } });
    RUN({ PM(1, phase_filt2(args, lds, tid, G)); if (DUP & 16) phase_filt2(args, lds, tid, G); PM(2, phase_adaln(args, 0, lane, wave, G)); if (DUP & 64) { for (int i = 0; i < 40; ++i) xcd_barrier(xbar); } });
#pragma unroll 1
    for (int l = 0; l < NL; ++l) {
        RUN(PM(3, { pg8::Gemm g{(const bf16*)(args.ws + WS_H), (const bf16*)(args.ws + WS_WIN) + (size_t)l * 6144 * 2048, MROWS, DIN, DM};
              pg8::StaticOrder S; S.init(MROWS, DIN, G, (int)blockIdx.x);
              pg8::EpiIn E{(bf16*)(args.ws + WS_P), (bf16*)(args.ws + WS_ZT), MROWS};
              pg8::gemm_phase<pg8::EpiIn, pg8::StaticOrder, true, true>((PG8_LAS unsigned char*)lds_raw, g, S, E, tid);
              if (DUP & 1) pg8::gemm_phase<pg8::EpiIn, pg8::StaticOrder, true, true>((PG8_LAS unsigned char*)lds_raw, g, S, E, tid); }));
        RUN({ PM(5, prep_qkv(args, l, lane, wave, G)); });
        RUN({ PM(6, prep_chunkmlp(args, l, lds, tid, lane, wave, G)); if (DUP & 32) { prep_chunkmlp(args, l, lds, tid, lane, wave, G); }
              PM(7, phase_mix<0xF>(args, l, lds, tid, G)); if (DUP & 2) phase_mix<0x1>(args, l, lds, tid, G); if (DUP & 4) phase_mix<0x2>(args, l, lds, tid, G); if (DUP & 8) phase_mix<0xC>(args, l, lds, tid, G); });
        RUN({ phase_ytr(args, lds, tid, G); if (DUP & 1024) phase_ytr(args, lds, tid, G); });
        RUN(PM(3, { pg8::Gemm g{(const bf16*)(args.ws + WS_MIX), (const bf16*)(args.ws + WS_WOUT) + (size_t)l * 2048 * 2048, MROWS, DM, DM};
              pg8::StaticOrder S; S.init(MROWS, DM, G, (int)blockIdx.x);
              pg8::EpiResid E{l, ALPHA, 0};
              if (DUP & 256) { pg8::EpiResid E2{l, ALPHA, 1}; pg8::gemm_phase<pg8::EpiResid, pg8::StaticOrder, true, true>((PG8_LAS unsigned char*)lds_raw, g, S, E2, tid); }
              pg8::gemm_phase<pg8::EpiResid, pg8::StaticOrder, true, true>((PG8_LAS unsigned char*)lds_raw, g, S, E, tid); }));
        RUN({ PM(2, phase_adaln(args, l + 1, lane, wave, G)); if ((DUP & 128) && l + 1 < NL) phase_adaln(args, l + 1, lane, wave, G); });
    }
#undef RUN
}

extern "C" void kernel_launch(void* const* d_in, const int* in_sizes, int n_in, void* d_out, int out_size, void* d_ws, size_t ws_size, hipStream_t stream) {
    static int grid = 0;
    if (grid == 0) {
        if (n_in != 27 || ws_size < WS_END) { fprintf(stderr, "kernel_launch: unexpected n_in %d / ws_size %zu\n", n_in, ws_size); grid = -1; return; }
        int dev = 0, cus = 0, per_cu = 0;
        (void)hipGetDevice(&dev); (void)hipDeviceGetAttribute(&cus, hipDeviceAttributeMultiprocessorCount, dev);
        if (hipFuncSetAttribute((const void*)fwd_megakernel, hipFuncAttributeMaxDynamicSharedMemorySize, LDS_BYTES) != hipSuccess) { fprintf(stderr, "kernel_launch: hipFuncSetAttribute failed\n"); grid = -1; return; }
        if (hipOccupancyMaxActiveBlocksPerMultiprocessor(&per_cu, (const void*)fwd_megakernel, 512, LDS_BYTES) != hipSuccess || per_cu < 1) per_cu = 1;
        (void)hipGetLastError();
        grid = cus * 1;
        fprintf(stderr, "kernel_launch: cus %d per_cu %d grid %d\n", cus, per_cu, grid);
    }
    if (grid < 0) return;
    if (hipMemsetAsync(d_ws, 0, 16384, stream) != hipSuccess) { fprintf(stderr, "kernel_launch: memset failed\n"); return; }
    Args a{};
    for (int i = 0; i < 27; ++i) a.in[i] = (const float*)d_in[i];
    a.out = (float*)d_out; a.ws = (unsigned char*)d_ws;
#if MULTI_LAUNCH
    for (int p = 0; p < N_PHASES; ++p) { a.ph_lo = p; a.ph_hi = p + 1; hipLaunchKernelGGL(fwd_megakernel, dim3(grid), dim3(512), LDS_BYTES, stream, a); }
#else
    a.ph_lo = 0; a.ph_hi = N_PHASES;
    void* kargs[] = {&a};
    hipError_t e = hipLaunchCooperativeKernel((const void*)fwd_megakernel, dim3(grid), dim3(512), kargs, LDS_BYTES, stream);
    if (e != hipSuccess) fprintf(stderr, "cooperative launch failed: %s (grid %d)\n", hipGetErrorString(e), grid);
#endif
}
```

```cpp
#include <hip/hip_runtime.h>
#include <hip/hip_cooperative_groups.h>
#include <cstdio>
#include <cstdint>
namespace cg = cooperative_groups;

#ifndef MULTI_LAUNCH
#define MULTI_LAUNCH 0
#endif
#ifndef PMASK
#define PMASK 0xFFF
#endif
#ifndef DUP
#define DUP 0
#endif
#ifndef HYABL
#define HYABL 0
#endif

struct Args {
    const float* in[27]; float* out; unsigned char* ws; int ph_lo, ph_hi;
};
typedef const __attribute__((address_space(4))) Args* KArgsP;
template <class T> __device__ __forceinline__ T* as_global(T* p) { return (T*)(__attribute__((address_space(1))) T*)p; }
__device__ __forceinline__ Args load_args() {
    KArgsP kp = (KArgsP)__builtin_amdgcn_kernarg_segment_ptr();
    asm volatile("" : "+s"(kp));
    Args a;
#pragma unroll
    for (int i = 0; i < 27; ++i) a.in[i] = as_global(kp->in[i]);
    a.out = as_global(kp->out); a.ws = as_global(kp->ws); a.ph_lo = kp->ph_lo; a.ph_hi = kp->ph_hi;
    return a;
}
namespace pg8 {
#define PG8_LAS __attribute__((address_space(3)))
typedef unsigned short bf16_t;
typedef short bf16x8 __attribute__((ext_vector_type(8)));
typedef float f32x4 __attribute__((ext_vector_type(4)));
typedef unsigned u32x4 __attribute__((ext_vector_type(4)));
constexpr int BM = 256, BK = 64, HALF = 128, HTB = HALF * BK * 2, STAGE_BYTES = 8 * HTB, NXCD = 8, WGM = 8;

__host__ __device__ __forceinline__ int lds_byte(int r, int c) { const int st = (r >> 4) * 2 + (c >> 5), rr = r & 15, cc = c & 31, ob = rr * 64 + cc * 2; return st * 1024 + (ob ^ (((ob >> 9) & 1) << 5)); }
__host__ __device__ __forceinline__ void stage_rc(int b, int& R, int& C) { const int st = b / 1024, sb = b % 1024, swz = sb ^ (((sb >> 9) & 1) << 5); R = (st >> 1) * 16 + swz / 64; C = (st & 1) * 32 + (swz % 64) / 2; }
__host__ __device__ __forceinline__ int perm32(int rho) { const int n = rho >> 4, i = rho & 15; return 8 * (i >> 2) + 4 * n + (i & 3); }

struct Unit { int pm, pn; };
struct Gemm { const bf16_t* A; const bf16_t* Bt; int M, N, K; };

struct StaticOrder {
    int nM, nN, nwg, G, c;
    __host__ __device__ void init(int M, int N, int G_, int c_) { nM = M / BM; nN = N / BM; nwg = nM * nN; G = G_; c = c_; }
    __host__ __device__ bool next(int i, Unit& u) const {
        const long L = (long)i * G + c; if (L >= nwg) return false;
        int wgid = (int)L; { const int q = nwg / NXCD, r = nwg % NXCD, xcd = wgid % NXCD, off = wgid / NXCD; wgid = (xcd < r ? xcd * (q + 1) : r * (q + 1) + (xcd - r) * q) + off; }
        const int nig = WGM * nN, gid = wgid / nig, fm = gid * WGM, gsz = (nM - fm) < WGM ? (nM - fm) : WGM;
        u.pm = fm + ((wgid % nig) % gsz); u.pn = (wgid % nig) / gsz; return true;
    }
    __device__ __forceinline__ void a_ready(const Unit&) const {}
    __device__ __forceinline__ void done(const Unit&) const {}
};

__device__ __forceinline__ unsigned cvt_pk_bf16(float lo, float hi) { unsigned r; asm volatile("v_cvt_pk_bf16_f32 %0, %1, %2" : "=v"(r) : "v"(lo), "v"(hi)); return r; }

struct EpiBf16 {
    static constexpr bool PERM = true, AFTER_DRAIN = false;
    bf16_t* O; int ldc;
    __device__ __forceinline__ void operator()(const f32x4 (&acc)[2][2][4][2], const Unit& u, int wr, int wc, int fr, int fq) const {
        const int row0 = u.pm * BM + wr * 64 + fr; const int col0 = u.pn * BM + wc * 32 + 8 * fq;
#pragma unroll
        for (int ai = 0; ai < 2; ++ai)
#pragma unroll
            for (int m = 0; m < 4; ++m) { bf16_t* rowp = O + (size_t)(row0 + ai * HALF + m * 16) * ldc + col0;
#pragma unroll
                for (int bj = 0; bj < 2; ++bj) { const f32x4 v0 = acc[ai][bj][m][0], v1 = acc[ai][bj][m][1];
                    u32x4 w; w.x = cvt_pk_bf16(v0[0], v0[1]); w.y = cvt_pk_bf16(v0[2], v0[3]); w.z = cvt_pk_bf16(v1[0], v1[1]); w.w = cvt_pk_bf16(v1[2], v1[3]);
                    *(u32x4*)(rowp + bj * HALF) = w; } }
    }
};
struct EpiIn {
    static constexpr bool PERM = true, AFTER_DRAIN = false;
    bf16_t* O; bf16_t* ZT; int nrows;
    __device__ __forceinline__ void operator()(const f32x4 (&acc)[2][2][4][2], const Unit& u, int wr, int wc, int fr, int fq) const {
        const int row0 = u.pm * BM + wr * 64 + fr;
        if (u.pn >= 8) {
            const int col0 = (u.pn - 8) * BM + wc * 32 + 8 * fq;
#pragma unroll
            for (int ai = 0; ai < 2; ++ai)
#pragma unroll
                for (int m = 0; m < 4; ++m) { bf16_t* rowp = O + (size_t)(row0 + ai * HALF + m * 16) * 4096 + col0;
#pragma unroll
                    for (int bj = 0; bj < 2; ++bj) { const f32x4 v0 = acc[ai][bj][m][0], v1 = acc[ai][bj][m][1];
                        u32x4 w; w.x = cvt_pk_bf16(v0[0], v0[1]); w.y = cvt_pk_bf16(v0[2], v0[3]); w.z = cvt_pk_bf16(v1[0], v1[1]); w.w = cvt_pk_bf16(v1[2], v1[3]);
                        *(u32x4*)(rowp + bj * HALF) = w; } }
        } else {
            const int col0 = u.pn * BM + wc * 32 + 8 * fq;
            long zo = (long)col0 * nrows + row0;
#pragma unroll
            for (int ai = 0; ai < 2; ++ai)
#pragma unroll
                for (int m = 0; m < 4; ++m) {
#pragma unroll
                    for (int bj = 0; bj < 2; ++bj) { const f32x4 v0 = acc[ai][bj][m][0], v1 = acc[ai][bj][m][1];
                        const unsigned w0 = cvt_pk_bf16(v0[0], v0[1]), w1 = cvt_pk_bf16(v0[2], v0[3]), w2 = cvt_pk_bf16(v1[0], v1[1]), w3 = cvt_pk_bf16(v1[2], v1[3]);
                        bf16_t* zp = ZT + zo + (long)(bj * HALF) * nrows + (ai * HALF + m * 16);
                        zp[0] = (bf16_t)w0; zp[(long)nrows] = (bf16_t)(w0 >> 16); zp[2L * nrows] = (bf16_t)w1; zp[3L * nrows] = (bf16_t)(w1 >> 16);
                        zp[4L * nrows] = (bf16_t)w2; zp[5L * nrows] = (bf16_t)(w2 >> 16); zp[6L * nrows] = (bf16_t)w3; zp[7L * nrows] = (bf16_t)(w3 >> 16); }
                    asm volatile("" : "+v"(zo) :: "memory"); }
        }
    }
};
struct EpiResid {
    static constexpr bool PERM = true, AFTER_DRAIN = false;
    int l; float alpha; int dup;
    __device__ __forceinline__ void operator()(const f32x4 (&acc)[2][2][4][2], const Unit& u, int wr, int wc, int fr, int fq) const {
        const Args a = load_args();
        bf16_t* Ub = (bf16_t*)a.out; float* Xf = (float*)(a.ws + (312u << 20)); const float* xin_p = a.in[0]; const float* xin_s = a.in[1]; const float* stats = (const float*)(a.ws + (936u << 20));
        const int use_ln = l > 0; const bool last = (l == 3); const float* lng = a.in[25] + (use_ln ? (l - 1) * 2048 : 0); const float* lnb = a.in[26] + (use_ln ? (l - 1) * 2048 : 0);
        const float* modl = (const float*)(a.ws + (1u << 20)) + (size_t)l * 9 * 6144;
        const int row0 = u.pm * BM + wr * 64 + fr; const int col0 = u.pn * BM + wc * 32 + 8 * fq;
        const int cond = (u.pm < 16) ? 8 : ((u.pm - 16) >> 4);
        const float* gate = modl + cond * 6144 + 4096 + col0;
        const float* src = (u.pm < 16 ? xin_p : xin_s); const int roff = (u.pm < 16) ? 0 : -4096;
        f32x4 gv[2][2], lg[2][2], lb[2][2];
#pragma unroll
        for (int bj = 0; bj < 2; ++bj)
#pragma unroll
            for (int n = 0; n < 2; ++n) { gv[bj][n] = *(const f32x4*)(gate + bj * HALF + n * 4);
                if (use_ln) { lg[bj][n] = *(const f32x4*)(lng + col0 + bj * HALF + n * 4); lb[bj][n] = *(const f32x4*)(lnb + col0 + bj * HALF + n * 4); }
                else { lg[bj][n] = (f32x4){1.f, 1.f, 1.f, 1.f}; lb[bj][n] = (f32x4){0.f, 0.f, 0.f, 0.f}; } }
#pragma unroll
        for (int ai = 0; ai < 2; ++ai)
#pragma unroll
            for (int m = 0; m < 4; ++m) { const int row = row0 + ai * HALF + m * 16;
                float mu = 0.f, rs = 1.f; if (use_ln) { const float* sp = stats + 2 * (size_t)row; mu = sp[0]; rs = sp[1]; }
                const float* sp2 = src + (size_t)(row + roff) * 2048 + col0; bf16_t* up = Ub + (size_t)row * 2048 + col0; float* xp = Xf + (size_t)row * 2048 + col0;
#pragma unroll
                for (int bj = 0; bj < 2; ++bj) { f32x4 x0, x1;
                    if (use_ln) { const u32x4 w = *(const u32x4*)(up + bj * HALF);
                        x0 = (f32x4){__builtin_bit_cast(float, w.x << 16), __builtin_bit_cast(float, w.x & 0xffff0000u), __builtin_bit_cast(float, w.y << 16), __builtin_bit_cast(float, w.y & 0xffff0000u)};
                        x1 = (f32x4){__builtin_bit_cast(float, w.z << 16), __builtin_bit_cast(float, w.z & 0xffff0000u), __builtin_bit_cast(float, w.w << 16), __builtin_bit_cast(float, w.w & 0xffff0000u)}; }
                    else { x0 = *(const f32x4*)(sp2 + bj * HALF); x1 = *(const f32x4*)(sp2 + bj * HALF + 4); }
                    x0 = (x0 - mu) * rs * lg[bj][0] + lb[bj][0]; x1 = (x1 - mu) * rs * lg[bj][1] + lb[bj][1];
                    x0 = x0 * alpha + gv[bj][0] * acc[ai][bj][m][0]; x1 = x1 * alpha + gv[bj][1] * acc[ai][bj][m][1];
                    if (dup) { *(f32x4*)(xp + bj * HALF) = x0; *(f32x4*)(xp + bj * HALF + 4) = x1; }
                    else { bf16_t* wp = last ? (bf16_t*)Xf + (size_t)row * 2048 + col0 : up; u32x4 o; o.x = cvt_pk_bf16(x0[0], x0[1]); o.y = cvt_pk_bf16(x0[2], x0[3]); o.z = cvt_pk_bf16(x1[0], x1[1]); o.w = cvt_pk_bf16(x1[2], x1[3]); *(u32x4*)(wp + bj * HALF) = o; } } }
    }
};

template <class Epi, class Sched, bool ALIGN_EPI = false, bool SP2 = false>
__device__ __forceinline__ void gemm_phase(PG8_LAS unsigned char* lds, const Gemm g, const Sched& S, const Epi& E, const int tid) {
    const int wid = __builtin_amdgcn_readfirstlane(tid >> 6), lane = tid & 63, wr = wid >> 2, wc = wid & 3, fr = lane & 15, fq = lane >> 4;
    const int K = g.K, nt = K / BK;
    unsigned voffA[2], voffB[2];
#pragma unroll
    for (int i = 0; i < 2; ++i) { int R, C; stage_rc(tid * 16 + i * 8192, R, C); const int Rb = Epi::PERM ? ((R & ~31) + perm32(R & 31)) : R;
        voffA[i] = (unsigned)(R * K + C) * 2u; voffB[i] = (unsigned)(Rb * K + C) * 2u; }
    const size_t kstep = (size_t)(BK * 2);
    const size_t hstep = (size_t)HALF * K * 2;
    const size_t tstep = 2 * hstep;
    const unsigned ldsw = (unsigned)wid * 1024u;
    const int aoff = lds_byte(wr * 64 + fr, fq * 8), boff = lds_byte(wc * 32 + fr, fq * 8);
#define PG8_SA(b, h) (((b) * 2 + (h)) * HTB)
#define PG8_SB(b, h) ((4 + (b) * 2 + (h)) * HTB)
#define PG8_STAGE(bufoff, gbase, voff) do { _Pragma("unroll") for (int _i = 0; _i < 2; ++_i) \
        __builtin_amdgcn_global_load_lds((const unsigned*)((const char*)(gbase) + (voff)[_i]), (PG8_LAS unsigned*)(lds + (bufoff) + ldsw + _i * 8192), 16, 0, 0); } while (0)
#define PG8_LDA(dst, b, h) do { _Pragma("unroll") for (int m = 0; m < 4; ++m) _Pragma("unroll") for (int k = 0; k < 2; ++k) dst[m][k] = *(const PG8_LAS bf16x8*)(lds + PG8_SA(b, h) + aoff + m * 2048 + k * 1024); } while (0)
#define PG8_LDB(dst, b, h) do { _Pragma("unroll") for (int n = 0; n < 2; ++n) _Pragma("unroll") for (int k = 0; k < 2; ++k) dst[n][k] = *(const PG8_LAS bf16x8*)(lds + PG8_SB(b, h) + boff + n * 2048 + k * 1024); } while (0)
#define PG8_MMA(ai, bj, At, Bt) do { __builtin_amdgcn_s_setprio(1); _Pragma("unroll") for (int m = 0; m < 4; ++m) _Pragma("unroll") for (int n = 0; n < 2; ++n) _Pragma("unroll") for (int k = 0; k < 2; ++k) \
        acc[ai][bj][m][n] = __builtin_amdgcn_mfma_f32_16x16x32_bf16(Bt[n][k], At[m][k], acc[ai][bj][m][n], 0, 0, 0); __builtin_amdgcn_s_setprio(0); } while (0)
#define PG8_WAIT_V(n) asm volatile("s_waitcnt vmcnt(" #n ")" ::: "memory")
#define PG8_WAIT_L(n) asm volatile("s_waitcnt lgkmcnt(" #n ")" ::: "memory")
#define PG8_BAR __builtin_amdgcn_s_barrier()
#define PG8_SCHED __builtin_amdgcn_sched_barrier(0)
    Unit cur, nxt; int ui = 0;
    if (!S.next(0, cur)) return;
    f32x4 acc[2][2][4][2];
#pragma unroll
    for (int a = 0; a < 2; ++a)
#pragma unroll
        for (int b = 0; b < 2; ++b)
#pragma unroll
            for (int m = 0; m < 4; ++m)
#pragma unroll
                for (int n = 0; n < 2; ++n) acc[a][b][m][n] = (f32x4){0.f, 0.f, 0.f, 0.f};
    bf16x8 At[4][2], B0[2][2], B1[2][2];
    const char* cA = (const char*)g.A + (size_t)cur.pm * tstep; const char* cB = (const char*)g.Bt + (size_t)cur.pn * tstep;
    S.a_ready(cur);
    if constexpr (SP2) {
        PG8_STAGE(PG8_SB(0, 0), cB, voffB); PG8_STAGE(PG8_SB(0, 1), cB + hstep, voffB); PG8_STAGE(PG8_SA(0, 0), cA, voffA); PG8_STAGE(PG8_SA(0, 1), cA + hstep, voffA);
        if (wr == 1) PG8_BAR;
        PG8_WAIT_V(2); PG8_BAR;
        PG8_STAGE(PG8_SB(1, 0), cB + kstep, voffB); PG8_STAGE(PG8_SA(1, 0), cA + kstep, voffA); PG8_STAGE(PG8_SB(1, 1), cB + hstep + kstep, voffB);
        PG8_WAIT_V(6); PG8_BAR;
    } else {
        PG8_STAGE(PG8_SB(0, 0), cB, voffB); PG8_STAGE(PG8_SA(0, 0), cA, voffA); PG8_STAGE(PG8_SB(0, 1), cB + hstep, voffB); PG8_STAGE(PG8_SA(0, 1), cA + hstep, voffA);
        if (wr == 1) PG8_BAR;
        PG8_WAIT_V(4); PG8_BAR;
        PG8_STAGE(PG8_SB(1, 0), cB + kstep, voffB); PG8_STAGE(PG8_SA(1, 0), cA + kstep, voffA); PG8_STAGE(PG8_SB(1, 1), cB + hstep + kstep, voffB);
        PG8_WAIT_V(6); PG8_BAR;
    }
    for (;;) {
        const bool has_next = S.next(ui + 1, nxt);
        const char* nA = has_next ? (const char*)g.A + (size_t)nxt.pm * tstep : cA; const char* nB = has_next ? (const char*)g.Bt + (size_t)nxt.pn * tstep : cB;
        for (int t = 0; t < nt; t += 2) {
            const bool last = (t == nt - 2);
            const char* a1 = cA + (size_t)(t + 1) * kstep;
            const char* a2 = last ? nA : cA + (size_t)(t + 2) * kstep; const char* b2 = last ? nB : cB + (size_t)(t + 2) * kstep;
            const char* a3 = a2 + kstep; const char* b3 = b2 + kstep;
            if (last && has_next) S.a_ready(nxt);
            if constexpr (SP2) {
            PG8_LDB(B0, 0, 0); PG8_LDB(B1, 0, 1); PG8_SCHED; PG8_LDA(At, 0, 0); PG8_STAGE(PG8_SA(1, 1), a1 + hstep, voffA);
            PG8_WAIT_V(8); PG8_WAIT_L(0); PG8_BAR; PG8_MMA(0, 0, At, B0); PG8_MMA(0, 1, At, B1); PG8_BAR; PG8_SCHED;
            PG8_LDA(At, 0, 1); PG8_STAGE(PG8_SB(0, 0), b2, voffB); PG8_STAGE(PG8_SB(0, 1), b2 + hstep, voffB); PG8_STAGE(PG8_SA(0, 0), a2, voffA);
            PG8_WAIT_V(8); PG8_WAIT_L(0); PG8_BAR; PG8_MMA(1, 0, At, B0); PG8_MMA(1, 1, At, B1); PG8_BAR; PG8_SCHED;
            PG8_LDB(B0, 1, 0); PG8_LDB(B1, 1, 1); PG8_SCHED; PG8_LDA(At, 1, 0); PG8_STAGE(PG8_SA(0, 1), a2 + hstep, voffA);
            PG8_WAIT_V(8); PG8_WAIT_L(0); PG8_BAR; PG8_MMA(0, 0, At, B0); PG8_MMA(0, 1, At, B1); PG8_BAR; PG8_SCHED;
            PG8_LDA(At, 1, 1); PG8_STAGE(PG8_SB(1, 0), b3, voffB); PG8_STAGE(PG8_SB(1, 1), b3 + hstep, voffB); PG8_STAGE(PG8_SA(1, 0), a3, voffA);
            PG8_WAIT_V(8); PG8_WAIT_L(0); PG8_BAR; PG8_MMA(1, 0, At, B0); PG8_MMA(1, 1, At, B1); PG8_BAR; PG8_SCHED;
            } else {
            PG8_LDB(B0, 0, 0); PG8_SCHED; PG8_LDA(At, 0, 0); PG8_STAGE(PG8_SA(1, 1), a1 + hstep, voffA);
            PG8_WAIT_L(8); PG8_BAR; PG8_WAIT_L(0); PG8_MMA(0, 0, At, B0); PG8_BAR; PG8_SCHED;
            PG8_LDB(B1, 0, 1); PG8_STAGE(PG8_SB(0, 0), b2, voffB);
            PG8_BAR; PG8_WAIT_L(0); PG8_MMA(0, 1, At, B1); PG8_BAR;
            PG8_LDA(At, 0, 1); PG8_STAGE(PG8_SA(0, 0), a2, voffA);
            PG8_BAR; PG8_WAIT_L(0); PG8_MMA(1, 0, At, B0); PG8_BAR; PG8_SCHED;
            PG8_STAGE(PG8_SB(0, 1), b2 + hstep, voffB);
            PG8_WAIT_V(6); PG8_BAR; PG8_MMA(1, 1, At, B1); PG8_BAR;
            PG8_LDB(B0, 1, 0); PG8_SCHED; PG8_LDA(At, 1, 0); PG8_STAGE(PG8_SA(0, 1), a2 + hstep, voffA);
            PG8_WAIT_L(8); PG8_BAR; PG8_WAIT_L(0); PG8_MMA(0, 0, At, B0); PG8_BAR; PG8_SCHED;
            PG8_LDB(B1, 1, 1); PG8_STAGE(PG8_SB(1, 0), b3, voffB);
            PG8_BAR; PG8_WAIT_L(0); PG8_MMA(0, 1, At, B1); PG8_BAR;
            PG8_LDA(At, 1, 1); PG8_STAGE(PG8_SA(1, 0), a3, voffA);
            PG8_BAR; PG8_WAIT_L(0); PG8_MMA(1, 0, At, B0); PG8_BAR; PG8_SCHED;
            PG8_STAGE(PG8_SB(1, 1), b3 + hstep, voffB);
            PG8_WAIT_V(6); PG8_BAR; PG8_MMA(1, 1, At, B1); PG8_BAR;
            }
        }
        if constexpr (ALIGN_EPI) { if (wr == 0) PG8_BAR; }
        if constexpr (!Epi::AFTER_DRAIN) { E(acc, cur, wr, wc, fr, fq); S.done(cur); }
        if (!has_next) break;
#pragma unroll
        for (int a = 0; a < 2; ++a)
#pragma unroll
            for (int b = 0; b < 2; ++b)
#pragma unroll
                for (int m = 0; m < 4; ++m)
#pragma unroll
                    for (int n = 0; n < 2; ++n) acc[a][b][m][n] = (f32x4){0.f, 0.f, 0.f, 0.f};
        cur = nxt; cA = nA; cB = nB; ++ui;
        if constexpr (ALIGN_EPI) { if (wr == 1) PG8_BAR; }
    }
    PG8_WAIT_V(0);
    if constexpr (!ALIGN_EPI) { if (wr == 0) PG8_BAR; }
    PG8_BAR;
#undef PG8_SA
#undef PG8_SB
#undef PG8_STAGE
#undef PG8_LDA
#undef PG8_LDB
#undef PG8_MMA
#undef PG8_WAIT_V
#undef PG8_WAIT_L
#undef PG8_BAR
#undef PG8_SCHED
}
}

typedef unsigned short bf16;
typedef short bf16x8 __attribute__((ext_vector_type(8)));
typedef short s16x4 __attribute__((ext_vector_type(4)));
typedef float f32x4 __attribute__((ext_vector_type(4)));
typedef float f32x2 __attribute__((ext_vector_type(2)));
typedef float f32x16 __attribute__((ext_vector_type(16)));
typedef unsigned u32x4 __attribute__((ext_vector_type(4)));
typedef unsigned u32x2 __attribute__((ext_vector_type(2)));

__device__ __forceinline__ unsigned f2bf(float f) { unsigned u = __builtin_bit_cast(unsigned, f); return (u + 0x7fffu + ((u >> 16) & 1u)) >> 16; }
__device__ __forceinline__ unsigned pk2(float lo, float hi) { return pg8::cvt_pk_bf16(lo, hi); }
__device__ __forceinline__ float bflo(unsigned w) { return __builtin_bit_cast(float, w << 16); }
__device__ __forceinline__ float bfhi(unsigned w) { return __builtin_bit_cast(float, w & 0xffff0000u); }
__device__ __forceinline__ float bf2f(bf16 h) { return __builtin_bit_cast(float, (unsigned)h << 16); }
__device__ __forceinline__ float wave_sum(float v) {
#pragma unroll
    for (int o = 1; o < 64; o <<= 1) v += __shfl_xor(v, o);
    return v;
}
__device__ __forceinline__ float silu_f(float v) { return v * __builtin_amdgcn_rcpf(1.f + __builtin_amdgcn_exp2f(-1.4426950408889634f * v)); }
__device__ __forceinline__ float hw_sin(float rad) { float r = rad * 0.15915494309189535f; r = r - floorf(r); return __builtin_amdgcn_sinf(r); }
__device__ __forceinline__ float hw_cos(float rad) { float r = rad * 0.15915494309189535f; r = r - floorf(r); return __builtin_amdgcn_cosf(r); }

constexpr int DM = 2048, DIN = 6144, NL = 4;
constexpr int MP = 4096, MROWS = 36864;
constexpr int LP = 256, LS = 4096, SKV_S = 4352;
constexpr float ALPHA = 1.681792830507429f;
constexpr float LN_EPS = 1e-6f;
constexpr int PST = 4096;
constexpr int C_CMU = 0, C_CMV = 512, C_CMG = 1024, C_Q = 1536, C_K = 2560, C_V = 2816, C_ATG = 3072;
constexpr int FLEN_S = 4096 + 128 + 16, FLEN_P = 256 + 64 + 16;
constexpr size_t MiB = 1u << 20;
constexpr size_t WS_MOD = 1 * MiB;
constexpr size_t WS_FS = 2 * MiB;
constexpr size_t WS_FP = 36 * MiB;
constexpr size_t WS_WIN = 40 * MiB;
constexpr size_t WS_WOUT = 136 * MiB;
constexpr size_t WS_H = 168 * MiB;
constexpr size_t WS_P = 312 * MiB;
constexpr size_t WS_ZT = 600 * MiB;
constexpr size_t WS_MIX = 744 * MiB;
constexpr size_t WS_KL = 888 * MiB, WS_VL = 906 * MiB;
constexpr size_t WS_KP = 924 * MiB, WS_VP = 926 * MiB;
constexpr size_t WS_H2 = 928 * MiB;
constexpr size_t WS_STATS = 936 * MiB; static_assert(WS_STATS == ((size_t)936u << 20) && WS_MOD == ((size_t)1u << 20) && WS_P == ((size_t)312u << 20), "EpiResid hard-codes these two offsets");
constexpr size_t WS_YT = 940 * MiB;
constexpr size_t WS_END = 976 * MiB;
constexpr int LDS_BYTES = 163840;


__device__ __forceinline__ void p0_transpose_item(const float* W, int K, int N, bf16* WT, float* scr, int item, int lane) {
    const int nblk = N / 32, kb = item / nblk, nb = item % nblk, k0 = 64 * kb, n0 = 32 * nb;
#pragma unroll 8
    for (int i = 0; i < 32; ++i) { const int kk = 2 * i + (lane >> 5); scr[kk * 33 + (lane & 31)] = W[(size_t)(k0 + kk) * N + n0 + (lane & 31)]; }
    asm volatile("s_waitcnt lgkmcnt(0)" ::: "memory");
    const int c = lane & 7;
#pragma unroll
    for (int j = 0; j < 4; ++j) { const int n = (lane >> 3) + 8 * j; const float* s = scr + (8 * c) * 33 + n;
        u32x4 o; o.x = pk2(s[0 * 33], s[1 * 33]); o.y = pk2(s[2 * 33], s[3 * 33]); o.z = pk2(s[4 * 33], s[5 * 33]); o.w = pk2(s[6 * 33], s[7 * 33]);
        *(u32x4*)(WT + (size_t)(n0 + n) * K + k0 + 8 * c) = o; }
    asm volatile("s_waitcnt lgkmcnt(0)" ::: "memory");
}

__device__ __forceinline__ void phase0(const Args& a, char* lds, int tid, int lane, int wave, int G) {
    const int gw = blockIdx.x * 8 + wave, NGW = G * 8;
    {
        float* h2buf = (float*)(a.ws + WS_H2);
        for (int task = gw; task < NL * 4352; task += NGW) {
            const int l = task / 4352, tt = task % 4352; const int L = tt < 256 ? 256 : 4096; const int pos = tt < 256 ? tt : tt - 256;
            const float* w1 = a.in[11] + l * 33 * 64; const float* b1 = a.in[12] + l * 64; const float* w2 = a.in[13] + l * 64 * 64; const float* b2 = a.in[14] + l * 64;
            const float fr = a.in[16][l * 64 + lane];
            float pre = b1[lane] + ((float)pos / (float)(L - 1)) * w1[lane];
#pragma unroll
            for (int i = 0; i < 16; ++i) {
                const float fb = 1e-4f + (float)i * ((15.0f - 1e-4f) / 15.0f);
                float rev = ((float)pos * fb) / (float)L; rev = rev - floorf(rev);
                const float cs = __builtin_amdgcn_cosf(rev), sn = __builtin_amdgcn_sinf(rev);
                pre += cs * w1[(1 + i) * 64 + lane] - sn * w1[(17 + i) * 64 + lane];
            }
            const float h1 = hw_sin(fr * pre);
            float pre2 = b2[lane];
#pragma unroll 16
            for (int i = 0; i < 64; ++i) pre2 += __shfl(h1, i) * w2[i * 64 + lane];
            h2buf[(size_t)(l * 4352 + tt) * 64 + lane] = hw_sin(fr * pre2);
        }
    }
    {
        float* scr = (float*)(lds + wave * 8448);
        constexpr int I_IN = 32 * 192, I_OUT = 32 * 64;
        for (int it = gw; it < NL * (I_IN + I_OUT); it += NGW) {
            const int l = it / (I_IN + I_OUT); int r = it % (I_IN + I_OUT);
            if (r < I_IN) p0_transpose_item(a.in[8] + (size_t)l * 2048 * 6144, 2048, 6144, (bf16*)(a.ws + WS_WIN) + (size_t)l * 6144 * 2048, scr, r, lane);
            else p0_transpose_item(a.in[24] + (size_t)l * 2048 * 2048, 2048, 2048, (bf16*)(a.ws + WS_WOUT) + (size_t)l * 2048 * 2048, scr, r - I_IN, lane);
        }
    }
    __syncthreads();
    {
        float* sil = (float*)lds;
        float* red = (float*)(lds + 2048 * 12 * 4);
        for (int idx = tid; idx < 9 * 2048; idx += 512) { const int cond = idx >> 11, k = idx & 2047;
            const float v = cond < 8 ? a.in[4][cond * 2048 + k] : a.in[5][k]; sil[k * 12 + cond] = silu_f(v); }
        __syncthreads();
        float* mod = (float*)(a.ws + WS_MOD);
        for (int item = blockIdx.x; item < NL * 96; item += G) {
            const int l = item / 96, n0 = (item % 96) * 64;
            const float* wm = a.in[6] + (size_t)l * 2048 * 6144 + n0 + lane;
            float acc[9];
#pragma unroll
            for (int c = 0; c < 9; ++c) acc[c] = 0.f;
#pragma unroll 8
            for (int kk = 0; kk < 256; ++kk) { const int k = wave * 256 + kk; const float wv = wm[(size_t)k * 6144];
                const f32x4 s0 = *(const f32x4*)(sil + k * 12), s1 = *(const f32x4*)(sil + k * 12 + 4); const float s8 = sil[k * 12 + 8];
                acc[0] += s0[0] * wv; acc[1] += s0[1] * wv; acc[2] += s0[2] * wv; acc[3] += s0[3] * wv;
                acc[4] += s1[0] * wv; acc[5] += s1[1] * wv; acc[6] += s1[2] * wv; acc[7] += s1[3] * wv; acc[8] += s8 * wv; }
#pragma unroll
            for (int c = 0; c < 9; ++c) red[(wave * 9 + c) * 64 + lane] = acc[c];
            __syncthreads();
            for (int idx = tid; idx < 576; idx += 512) { const int c = idx >> 6, ln = idx & 63; float s = a.in[7][l * 6144 + n0 + ln];
#pragma unroll
                for (int w = 0; w < 8; ++w) s += red[(w * 9 + c) * 64 + ln];
                mod[(size_t)(l * 9 + c) * 6144 + n0 + ln] = s; }
            __syncthreads();
        }
    }
}

__device__ __forceinline__ void phase_filt2(const Args& a, char* lds, int tid, int G) {
    const float* h2buf = (const float*)(a.ws + WS_H2);
    float* h2s = (float*)lds;
    for (int item = blockIdx.x; item < NL * 2 * 34; item += G) {
        const int l = item / 68, r = item % 68, order = r / 34, ch = r % 34;
        const bool isS = ch < 32; const int L = isS ? 4096 : 256, P = isS ? 64 : 32, FLEN = isS ? FLEN_S : FLEN_P;
        const int t0 = isS ? ch * 128 : (ch - 32) * 128, ttbase = isS ? 256 : 0;
        const int c = tid;
        bf16* R = (bf16*)(a.ws + (isS ? WS_FS : WS_FP)) + (size_t)((l * 2 + order) * 512 + c) * FLEN;
        __syncthreads();
        for (int idx = tid; idx < 128 * 64; idx += 512) h2s[idx] = h2buf[(size_t)(l * 4352 + ttbase + t0) * 64 + idx];
        float w3r[64];
#pragma unroll
        for (int i = 0; i < 64; ++i) w3r[i] = a.in[15][(size_t)(l * 64 + i) * 1024 + order * 512 + c];
        __syncthreads();
        const float la = -4.605170185988091f / 1.5f, lb = -4.605170185988091f / 0.3f;
        const float delta = fabsf(la + (lb - la) * ((float)c / 511.0f));
        const int OFF = L / 2 + P;
        for (int tl = 0; tl < 128; ++tl) {
            const int t = t0 + tl; float s = 0.f;
#pragma unroll
            for (int i = 0; i < 64; i += 4) { const f32x4 hv = *(const f32x4*)(h2s + tl * 64 + i); s += hv[0] * w3r[i] + hv[1] * w3r[i + 1] + hv[2] * w3r[i + 2] + hv[3] * w3r[i + 3]; }
            const float dist = fabsf((float)(t - L / 2)) / (float)(L / 2);
            const float val = s * __expf(-dist * delta);
            R[OFF - (t - L / 2)] = (bf16)f2bf(val);
        }
        if (t0 == 0) { for (int i = 0; i <= P; ++i) R[i] = 0; for (int i = L + P + 1; i < FLEN; ++i) R[i] = 0; }
    }
    __syncthreads();
}

__device__ __forceinline__ void phase_adaln(const Args& a, int l, int lane, int wave, int G) {
    const int gw = blockIdx.x * 8 + wave, NGW = G * 8;
    float* X = a.out; const bf16* Ub = (const bf16*)a.out; const bf16* Ul = (const bf16*)(a.ws + WS_P);
    bf16* H = (bf16*)(a.ws + WS_H); const float* mod = (const float*)(a.ws + WS_MOD); float* stats = (float*)(a.ws + WS_STATS);
    const bool do_ln = l > 0, write_h = l < NL;
    const float* lg = a.in[25] + (do_ln ? (l - 1) * 2048 : 0); const float* lb = a.in[26] + (do_ln ? (l - 1) * 2048 : 0);
    f32x4 g8[8], b8[8];
#pragma unroll
    for (int j = 0; j < 8; ++j) { const int col = 512 * (j >> 1) + 8 * lane + 4 * (j & 1); g8[j] = do_ln ? *(const f32x4*)(lg + col) : (f32x4){1.f, 1.f, 1.f, 1.f}; b8[j] = do_ln ? *(const f32x4*)(lb + col) : (f32x4){0.f, 0.f, 0.f, 0.f}; }
    const int per = (MROWS / 2 + NGW - 1) / NGW, rp0 = gw * per, rp1 = (rp0 + per < MROWS / 2) ? rp0 + per : MROWS / 2;
    f32x4 sh8[8], sc8[8]; int ccur = -1;
#pragma unroll
    for (int j = 0; j < 8; ++j) { sh8[j] = (f32x4){0.f, 0.f, 0.f, 0.f}; sc8[j] = (f32x4){1.f, 1.f, 1.f, 1.f}; }
    for (int rowp = rp0; rowp < rp1; ++rowp) {
        f32x4 v[2][8]; float s[2] = {0.f, 0.f};
#pragma unroll
        for (int rr = 0; rr < 2; ++rr) { const int row = 2 * rowp + rr;
            if (l > 0) { const bf16* ub = ((l < NL) ? Ub : Ul) + (size_t)row * 2048 + 8 * lane;
#pragma unroll
                for (int j = 0; j < 4; ++j) { const u32x4 w = *(const u32x4*)(ub + 512 * j);
                    v[rr][2 * j] = (f32x4){bflo(w.x), bfhi(w.x), bflo(w.y), bfhi(w.y)}; v[rr][2 * j + 1] = (f32x4){bflo(w.z), bfhi(w.z), bflo(w.w), bfhi(w.w)}; }
            } else { const float* src = (row < MP ? a.in[0] + (size_t)row * 2048 : a.in[1] + (size_t)(row - MP) * 2048) + 8 * lane;
#pragma unroll
                for (int j = 0; j < 4; ++j) { v[rr][2 * j] = *(const f32x4*)(src + 512 * j); v[rr][2 * j + 1] = *(const f32x4*)(src + 512 * j + 4); } } }
#pragma unroll
        for (int rr = 0; rr < 2; ++rr) { const int row = 2 * rowp + rr;
#pragma unroll
        for (int j = 0; j < 8; ++j) s[rr] += (v[rr][j][0] + v[rr][j][1]) + (v[rr][j][2] + v[rr][j][3]);
        if (do_ln) {
            const float mean = wave_sum(s[rr]) * (1.f / 2048.f); float q = 0.f;
#pragma unroll
            for (int j = 0; j < 8; ++j) { v[rr][j] = v[rr][j] - mean; q += (v[rr][j][0] * v[rr][j][0] + v[rr][j][1] * v[rr][j][1]) + (v[rr][j][2] * v[rr][j][2] + v[rr][j][3] * v[rr][j][3]); }
            const float rstd = 1.f / sqrtf(wave_sum(q) * (1.f / 2048.f) + LN_EPS);
            if (write_h && lane == 0) *(f32x2*)(stats + 2 * (size_t)row) = (f32x2){mean, rstd};
#pragma unroll
            for (int j = 0; j < 8; ++j) v[rr][j] = v[rr][j] * rstd * g8[j] + b8[j];
        }
        if (!write_h) {
#pragma unroll
            for (int j = 0; j < 8; ++j) *(f32x4*)(X + (size_t)row * 2048 + 512 * (j >> 1) + 8 * lane + 4 * (j & 1)) = v[rr][j];
        } else {
            const int cond = row < MP ? 8 : ((row - MP) >> 12);
            if (cond != ccur) { ccur = cond; const float* m = mod + (size_t)(l * 9 + cond) * 6144;
#pragma unroll
                for (int j = 0; j < 8; ++j) { const int col = 512 * (j >> 1) + 8 * lane + 4 * (j & 1); sh8[j] = *(const f32x4*)(m + col); sc8[j] = *(const f32x4*)(m + 2048 + col) + 1.f; } }
#pragma unroll
            for (int j = 0; j < 4; ++j) { const int col = 512 * j + 8 * lane;
                const f32x4 h0 = v[rr][2 * j] * sc8[2 * j] + sh8[2 * j], h1 = v[rr][2 * j + 1] * sc8[2 * j + 1] + sh8[2 * j + 1];
                u32x4 w; w.x = pk2(h0[0], h0[1]); w.y = pk2(h0[2], h0[3]); w.z = pk2(h1[0], h1[1]); w.w = pk2(h1[2], h1[3]);
                *(u32x4*)(H + (size_t)row * 2048 + col) = w; }
        }
        }
    }
}

__device__ __forceinline__ void prep_qkv(const Args& a, int l, int lane, int wave, int G) {
    const int gw = blockIdx.x * 8 + wave, NGW = G * 8;
    bf16* P = (bf16*)(a.ws + WS_P);
    bf16* KL = (bf16*)(a.ws + WS_KL); bf16* VL = (bf16*)(a.ws + WS_VL); bf16* KP = (bf16*)(a.ws + WS_KP); bf16* VP = (bf16*)(a.ws + WS_VP);
    float* nck = a.out + (size_t)MROWS * 2048; float* ncv = nck + (size_t)16 * 4 * 256 * 256;
    const int d0 = 8 * (lane & 15), hsub = lane >> 4;
    const f32x4 qg0 = *(const f32x4*)(a.in[22] + l * 128 + d0), qg1 = *(const f32x4*)(a.in[22] + l * 128 + d0 + 4);
    const f32x4 kg0 = *(const f32x4*)(a.in[23] + l * 128 + d0), kg1 = *(const f32x4*)(a.in[23] + l * 128 + d0 + 4);
    const int axis = (lane & 15) >> 3, half = (lane >> 2) & 1, f0 = 8 * (lane & 3);
    float inv[8];
#pragma unroll
    for (int i = 0; i < 8; ++i) inv[i] = exp2f(-(float)(f0 + i) * (13.287712379549449f / 32.f));
    for (int rowp = gw; rowp < MROWS / 2; rowp += NGW) {
        u32x4 rw[2][3], cmv[2];
#pragma unroll
        for (int rr = 0; rr < 2; ++rr) { const bf16* prow = P + (size_t)(2 * rowp + rr) * PST;
            cmv[rr] = *(const u32x4*)(prow + C_CMV + 8 * lane);
#pragma unroll
            for (int j = 0; j < 3; ++j) rw[rr][j] = *(const u32x4*)(prow + C_Q + 512 * j + 8 * lane); }
#pragma unroll
        for (int rr = 0; rr < 2; ++rr) {
        const int row = 2 * rowp + rr;
        {
            const u32x4 w = cmv[rr]; float x[8] = {bflo(w.x), bfhi(w.x), bflo(w.y), bfhi(w.y), bflo(w.z), bfhi(w.z), bflo(w.w), bfhi(w.w)}; float sm = 0.f;
#pragma unroll
            for (int j = 0; j < 8; ++j) sm += x[j];
            const float mean = wave_sum(sm) * (1.f / 512.f); float qq = 0.f;
#pragma unroll
            for (int j = 0; j < 8; ++j) { x[j] -= mean; qq += x[j] * x[j]; }
            const float rstd = 1.f / sqrtf(wave_sum(qq) * (1.f / 512.f) + LN_EPS);
            if (lane == 0) *(f32x2*)((float*)(a.ws + WS_STATS + 512 * 1024) + 2 * (size_t)row) = (f32x2){mean, rstd};
        }
        const bool lat = row >= MP; int b, s; float cs[8], sn[8];
        if (lat) { b = (row - MP) >> 12; s = (row - MP) & 4095; const float pos = (float)(axis ? (s & 63) : (s >> 6));
#pragma unroll
            for (int i = 0; i < 8; ++i) { const float ang = pos * inv[i]; cs[i] = hw_cos(ang); sn[i] = hw_sin(ang); } }
        else { b = row >> 8; s = row & 255;
#pragma unroll
            for (int i = 0; i < 8; ++i) { cs[i] = 1.f; sn[i] = 0.f; } }
        bf16* prow = P + (size_t)row * PST;
#pragma unroll
        for (int j = 0; j < 3; ++j) {
            const int hd = 4 * j + hsub;
            const u32x4 w = rw[rr][j]; float x[8] = {bflo(w.x), bfhi(w.x), bflo(w.y), bfhi(w.y), bflo(w.z), bfhi(w.z), bflo(w.w), bfhi(w.w)};
            float ss = 0.f;
#pragma unroll
            for (int i = 0; i < 8; ++i) ss += x[i] * x[i];
            ss += __shfl_xor(ss, 1); ss += __shfl_xor(ss, 2); ss += __shfl_xor(ss, 4); ss += __shfl_xor(ss, 8);
            const bool normed = hd < 10; const float r = normed ? 1.f / sqrtf(ss * (1.f / 128.f) + LN_EPS) : 1.f;
#pragma unroll
            for (int i = 0; i < 8; ++i) { const float g = !normed ? 1.f : (hd < 8 ? (i < 4 ? qg0[i & 3] : qg1[i & 3]) : (i < 4 ? kg0[i & 3] : kg1[i & 3])); x[i] = x[i] * r * g; }
            float u[8];
#pragma unroll
            for (int i = 0; i < 8; ++i) u[i] = x[i];
#pragma unroll
            for (int i = 0; i < 8; ++i) { const float p = __shfl_xor(x[i], 4);
                const float ro = half == 0 ? (u[i] * cs[i] - p * sn[i]) : (p * sn[i] + u[i] * cs[i]); x[i] = (lat && normed) ? ro : u[i]; }
            u32x4 ow; ow.x = pk2(x[0], x[1]); ow.y = pk2(x[2], x[3]); ow.z = pk2(x[4], x[5]); ow.w = pk2(x[6], x[7]);
            if (j < 2) { *(u32x4*)(prow + C_Q + 512 * j + 8 * lane) = ow; }
            else { const int kv = hsub & 1; const bool isk = hsub < 2;
                if (lat) { bf16* dst = (isk ? KL : VL) + ((size_t)(b * 2 + kv) * SKV_S + s) * 128 + d0; *(u32x4*)dst = ow; }
                else { bf16* dst = (isk ? KP : VP) + ((size_t)(b * 2 + kv) * LP + s) * 128 + d0; *(u32x4*)dst = ow;
                    float* o = (isk ? nck : ncv) + ((size_t)((b * 4 + l) * 256 + s) * 2 + kv) * 128 + d0;
                    *(f32x4*)o = (f32x4){u[0], u[1], u[2], u[3]}; *(f32x4*)(o + 4) = (f32x4){u[4], u[5], u[6], u[7]}; } }
        }
        }
    }
    for (int task = gw; task < 8 * 256 * 2; task += NGW) {
        const int kv = task & 1, j = (task >> 1) & 255, b = task >> 9;
        const size_t so = ((size_t)((b * 4 + l) * 256 + j) * 2 + kv) * 128 + 2 * lane;
        const f32x2 kx = *(const f32x2*)(a.in[2] + so), vx = *(const f32x2*)(a.in[3] + so);
        const size_t d = ((size_t)(b * 2 + kv) * SKV_S + 4096 + j) * 128 + 2 * lane;
        *(unsigned*)(KL + d) = pk2(kx[0], kx[1]); *(unsigned*)(VL + d) = pk2(vx[0], vx[1]);
    }
}

__device__ __forceinline__ void prep_chunkmlp(const Args& a, int l, char* lds, int tid, int lane, int wave, int G) {
    const bf16* P = (const bf16*)(a.ws + WS_P); bf16* MIX = (bf16*)(a.ws + WS_MIX);
    constexpr int VS = 288;
    char* vT = lds;
    const float* lng = a.in[18] + l * 512; const float* lnb = a.in[19] + l * 512;
    const int fr = lane & 15, fq = lane >> 4;
    for (int item = blockIdx.x; item < 288 * 4; item += G) {
        const int ci = item >> 2, hd = item & 3, r0 = ci * 128;
        __syncthreads();
        { const float* st2 = (const float*)(a.ws + WS_STATS + 512 * 1024);
          const int tsub = lane >> 4, chk = lane & 15, ch = 128 * hd + 8 * chk;
          const f32x4 lga = *(const f32x4*)(lng + ch), lgb = *(const f32x4*)(lng + ch + 4), lba = *(const f32x4*)(lnb + ch), lbb = *(const f32x4*)(lnb + ch + 4);
          u32x4 wt[4]; f32x2 sv[4];
#pragma unroll
          for (int i = 0; i < 4; ++i) { const int q = wave * 16 + 4 * i + tsub; wt[i] = *(const u32x4*)(P + (size_t)(r0 + q) * PST + C_CMV + ch); sv[i] = *(const f32x2*)(st2 + 2 * (size_t)(r0 + q)); }
#pragma unroll
          for (int i = 0; i < 4; ++i) { const int q = wave * 16 + 4 * i + tsub; const u32x4 w = wt[i]; const float mean = sv[i][0], rstd = sv[i][1];
              const float x[8] = {bflo(w.x), bfhi(w.x), bflo(w.y), bfhi(w.y), bflo(w.z), bfhi(w.z), bflo(w.w), bfhi(w.w)};
#pragma unroll
              for (int j = 0; j < 8; ++j) { const float gg = j < 4 ? lga[j & 3] : lgb[j & 3], bb = j < 4 ? lba[j & 3] : lbb[j & 3]; const float y = (x[j] - mean) * rstd * gg + bb;
                  *(bf16*)(vT + (8 * chk + j) * VS + q * 2) = (bf16)f2bf(y); } } }
        __syncthreads();
        const float* ws_ = a.in[20] + ((size_t)(l * 4 + hd) * 128 + wave * 16 + fr) * 128 + 8 * fq;
        bf16x8 wf[4];
#pragma unroll
        for (int kb = 0; kb < 4; ++kb) { const f32x4 lo = *(const f32x4*)(ws_ + 32 * kb), hi = *(const f32x4*)(ws_ + 32 * kb + 4);
            u32x4 w; w.x = pk2(lo[0], lo[1]); w.y = pk2(lo[2], lo[3]); w.z = pk2(hi[0], hi[1]); w.w = pk2(hi[2], hi[3]); wf[kb] = __builtin_bit_cast(bf16x8, w); }
        f32x4 acc[8];
#pragma unroll
        for (int ct = 0; ct < 8; ++ct) { acc[ct] = (f32x4){0.f, 0.f, 0.f, 0.f};
#pragma unroll
            for (int kb = 0; kb < 4; ++kb) { const bf16x8 vf = *(const bf16x8*)(vT + (16 * ct + fr) * VS + 64 * kb + 16 * fq);
                acc[ct] = __builtin_amdgcn_mfma_f32_16x16x32_bf16(vf, wf[kb], acc[ct], 0, 0, 0); } }
        const int pl = wave * 16 + fr, row = r0 + pl; const float bs = a.in[21][(l * 4 + hd) * 128 + pl];
        const bf16* prow = P + (size_t)row * PST; bf16* mrow = MIX + (size_t)row * 2048 + 512 + 128 * hd;
#pragma unroll
        for (int ct = 0; ct < 8; ++ct) { const int c4 = 16 * ct + 4 * fq;
            const u32x2 uw = *(const u32x2*)(prow + C_CMU + 128 * hd + c4), gw_ = *(const u32x2*)(prow + C_CMG + 128 * hd + c4);
            const float y0 = bflo(uw.x) * (acc[ct][0] + bs) * silu_f(bflo(gw_.x)), y1 = bfhi(uw.x) * (acc[ct][1] + bs) * silu_f(bfhi(gw_.x));
            const float y2 = bflo(uw.y) * (acc[ct][2] + bs) * silu_f(bflo(gw_.y)), y3 = bfhi(uw.y) * (acc[ct][3] + bs) * silu_f(bfhi(gw_.y));
            u32x2 o; o.x = pk2(y0, y1); o.y = pk2(y2, y3); *(u32x2*)(mrow + c4) = o; }
    }
    __syncthreads();
}

template <int L, int P, int NB, int ABL = 0>
__device__ __forceinline__ void hyena_item(const Args& a, int l, int c, char* lds, int tid, int lane, int wave) {
    constexpr int NT1 = L / P, NT = NB * NT1 / 16, MT = P / 16, KB = P / 32, D1MAX = (L / 2) / P, OFF = L / 2 + P, FLEN = L + 2 * P + 16, SROW = 2 * P + 32;
    constexpr bool FAST = (NB == 1);
    constexpr int ZW = (NB * NT1 + (FAST ? 1 : 0)) * SROW;
    constexpr int FOFF = 8 * ZW;
    constexpr int FB = ((FLEN * 2 + 15) / 16) * 16, CB = 8704;
    constexpr unsigned CPACK = 0x62DB0A62u;
#define HY_COFF(k) ((int)((CPACK >> (4 * (k))) & 15u))
    const bf16* ZT = (const bf16*)(a.ws + WS_ZT); bf16* MIX = (bf16*)(a.ws + WS_MIX);
    const bool isS = (L == 4096);
    const int seq0 = isS ? MP + wave * L : (2 * wave) * L;
    char* zw = lds + wave * ZW;
    const int n16 = lane & 15, q4 = lane >> 4;
    __syncthreads();
    const bf16* Rg = (const bf16*)(a.ws + (isS ? WS_FS : WS_FP));
    if constexpr (!FAST) {
      for (int idx = tid; idx < 2 * (FLEN / 8); idx += 512) { const int o = idx / (FLEN / 8), i = idx % (FLEN / 8);
          *(u32x4*)(lds + FOFF + o * FB + i * 16) = *(const u32x4*)(Rg + (size_t)((l * 2 + o) * 512 + c) * FLEN + i * 8); } }
    const float* cw = a.in[9] + l * 3 * 1536; const float* cb = a.in[10] + l * 1536;
    u32x4 xrA[MT][NT], xrB[MT][NT]; u32x2 grB[MT][NT];
    { const bf16* xg = ZT + (size_t)(512 + c) * MROWS + seq0 + (n16 * P + 4 * q4 - 2);
      const bf16* sg = ZT + (size_t)(1536 + c) * MROWS + seq0 + (n16 * P + 4 * q4);
#pragma unroll
      for (int nt = 0; nt < NT; ++nt)
#pragma unroll
          for (int mt = 0; mt < MT; ++mt) {
              if (!(ABL & 4)) { const unsigned* xa = (const unsigned*)(xg + (16 * nt * P + 16 * mt)); xrA[mt][nt] = (u32x4){xa[0], xa[1], xa[2], xa[3]};
                  const unsigned* xb = (const unsigned*)(xg + (size_t)512 * MROWS + (16 * nt * P + 16 * mt)); xrB[mt][nt] = (u32x4){xb[0], xb[1], xb[2], xb[3]};
                  grB[mt][nt] = *(const u32x2*)(sg + (16 * nt * P + 16 * mt)); }
              else { xrA[mt][nt] = (u32x4){0x3f803f80u, 0x3f803f80u, 0x3f803f80u, 0x3f803f80u}; xrB[mt][nt] = xrA[mt][nt]; grB[mt][nt] = (u32x2){0u, 0u}; } } }
    { const bf16* zr = ZT + (size_t)c * MROWS + seq0; const float w0 = cw[c], w1 = cw[1536 + c], w2 = cw[3072 + c], bb = cb[c];
#pragma unroll
      for (int ci = 0; ci < ((ABL & 16) ? 0 : NB * L / 512); ++ci) { const int ch = lane + 64 * ci; const int t = 8 * ch, tl = t & (L - 1);
          const u32x4 w = *(const u32x4*)(zr + t);
          float xp = bf2f(zr[t - 1]), xn = bf2f(zr[t + 8]);
          xp = tl == 0 ? 0.f : xp; xn = (tl + 8 == L) ? 0.f : xn;
          const float x0 = bflo(w.x), x1 = bfhi(w.x), x2 = bflo(w.y), x3 = bfhi(w.y), x4 = bflo(w.z), x5 = bfhi(w.z), x6 = bflo(w.w), x7 = bfhi(w.w);
          u32x4 o;
          o.x = pk2(xp * w0 + x0 * w1 + x1 * w2 + bb, x0 * w0 + x1 * w1 + x2 * w2 + bb); o.y = pk2(x1 * w0 + x2 * w1 + x3 * w2 + bb, x2 * w0 + x3 * w1 + x4 * w2 + bb);
          o.z = pk2(x3 * w0 + x4 * w1 + x5 * w2 + bb, x4 * w0 + x5 * w1 + x6 * w2 + bb); o.w = pk2(x5 * w0 + x6 * w1 + x7 * w2 + bb, x6 * w0 + x7 * w1 + xn * w2 + bb);
          *(u32x4*)(zw + (t / P) * SROW + (t % P) * 2) = o; }
      if (FAST && lane < SROW / 16) { unsigned z0; asm volatile("v_mov_b32 %0, 0" : "=v"(z0)); *(u32x4*)(zw + NT1 * SROW + 16 * lane) = (u32x4){z0, z0, z0, z0}; } }
    u32x2 gtA[MT][NT], gtB[MT][NT];
#define HY_GATECALC(oo, XR, GT) do { const int gc = 512 * ((oo) + 1) + c; const float gw0 = cw[gc], gw1 = cw[1536 + gc], gw2 = cw[3072 + gc], gbb = cb[gc]; \
        _Pragma("unroll") for (int nt = 0; nt < NT; ++nt) _Pragma("unroll") for (int mt = 0; mt < MT; ++mt) { \
            const int tl = ((16 * nt + n16) * P + 16 * mt + 4 * q4) & (L - 1); const u32x4 xw = XR[mt][nt]; \
            const float xp = tl == 0 ? 0.f : bfhi(xw.x), xn = (tl + 4 == L) ? 0.f : bflo(xw.w); \
            const float r0 = bflo(xw.y), r1 = bfhi(xw.y), r2 = bflo(xw.z), r3 = bfhi(xw.z); \
            float g0 = xp * gw0 + r0 * gw1 + r1 * gw2 + gbb, g1 = r0 * gw0 + r1 * gw1 + r2 * gw2 + gbb, g2 = r1 * gw0 + r2 * gw1 + r3 * gw2 + gbb, g3 = r2 * gw0 + r3 * gw1 + xn * gw2 + gbb; \
            if ((oo) == 1 && !(ABL & 4)) { const u32x2 gv = grB[mt][nt]; g0 *= silu_f(bflo(gv.x)); g1 *= silu_f(bfhi(gv.x)); g2 *= silu_f(bflo(gv.y)); g3 *= silu_f(bfhi(gv.y)); } \
            GT[mt][nt].x = pk2(g0, g1); GT[mt][nt].y = pk2(g2, g3); } } while (0)
    HY_GATECALC(0, xrA, gtA); HY_GATECALC(1, xrB, gtB);
#undef HY_GATECALC
    if constexpr (!FAST) __syncthreads();
#pragma unroll 1
    for (int o = 0; o < 2; ++o) {
        f32x4 acc[MT][NT];
#pragma unroll
        for (int mt = 0; mt < MT; ++mt)
#pragma unroll
            for (int nt = 0; nt < NT; ++nt) acc[mt][nt] = (f32x4){0.f, 0.f, 0.f, 0.f};
        u32x2 gt[MT][NT];
#pragma unroll
        for (int mt = 0; mt < MT; ++mt)
#pragma unroll
            for (int nt = 0; nt < NT; ++nt) { gt[mt][nt].x = o ? gtB[mt][nt].x : gtA[mt][nt].x; gt[mt][nt].y = o ? gtB[mt][nt].y : gtA[mt][nt].y; }
        if constexpr (FAST) {
            if (o) __syncthreads();
            { const unsigned* Rd = (const unsigned*)(Rg + (size_t)((l * 2 + o) * 512 + c) * FLEN); constexpr int ND = FLEN / 2;
#pragma unroll
              for (int mi = 0; mi < ((ABL & 8) ? 0 : (ND + 511) / 512); ++mi) { const int m = tid + 512 * mi; unsigned d[5];
                  if (m < ND) {
#pragma unroll
                  for (int i = 0; i < 5; ++i) d[i] = (m + i < ND) ? Rd[m + i] : 0u;
#pragma unroll
                  for (int k = 0; k < 8; ++k) { const unsigned v = (k & 1) ? __builtin_amdgcn_alignbit(d[(k + 1) / 2], d[(k - 1) / 2], 16u) : d[k / 2];
                      *(unsigned*)(lds + FOFF + k * CB + 16 * HY_COFF(k) + 4 * m) = v; } } } }
            __syncthreads();
            const int kk = (OFF - n16) & 7;
            const int abase = FOFF + kk * CB + 16 * HY_COFF(kk) + 2 * (OFF - n16 + 8 * q4 - kk) - 96;
            const int bbase = wave * ZW + n16 * SROW + 16 * q4;
            const int zrow = wave * ZW + NT1 * SROW + 16 * q4;
            static_assert(NT == 4 && NT1 == 64 && D1MAX == 32 && MT == 4 && KB == 2, "r-major loop below is for the latent shape");
#define HY_K(K_) do { bf16x8 a0[4], a1[4]; \
                _Pragma("unroll") for (int mt = 0; mt < 4; ++mt) a0[mt] = *(const bf16x8*)(lds + ar + (2048 * (1 - (K_)) + 32 * (3 - mt))); \
                a1[2] = a0[0]; a1[3] = a0[1]; \
                _Pragma("unroll") for (int mt = 0; mt < 2; ++mt) a1[mt] = *(const bf16x8*)(lds + ar + (2048 * (1 - (K_)) + 64 + 32 * (3 - mt))); \
                __builtin_amdgcn_s_setprio(1); \
                _Pragma("unroll") for (int nt = 0; nt < 4; ++nt) { const int j = nt - (K_); if (j < 0 || j > 4) continue; \
                    _Pragma("unroll") for (int mt = 0; mt < 4; ++mt) acc[mt][nt] = __builtin_amdgcn_mfma_f32_16x16x32_bf16(a0[mt], bt[j][0], acc[mt][nt], 0, 0, 0); \
                    _Pragma("unroll") for (int mt = 0; mt < 4; ++mt) acc[mt][nt] = __builtin_amdgcn_mfma_f32_16x16x32_bf16(a1[mt], bt[j][1], acc[mt][nt], 0, 0, 0); } \
                __builtin_amdgcn_s_setprio(0); } while (0)
#pragma unroll 1
            for (int r = 0; r < ((ABL & 2) ? 1 : 16); ++r) {
                bf16x8 bt[5][2];
#pragma unroll
                for (int j = 0; j < 5; ++j) { const bool ok = (unsigned)(16 * j + n16 - r) < (unsigned)NT1; const int ad = ok ? (bbase - r * SROW) : (zrow - 16 * SROW * j);
                    bt[j][0] = *(const bf16x8*)(lds + ad + (16 * SROW * j)); bt[j][1] = *(const bf16x8*)(lds + ad + (16 * SROW * j + 64)); }
                const int ar = abase - 128 * r - 2048;
                HY_K(-2); HY_K(-1); HY_K(0); HY_K(1);
            }
            {
                bf16x8 bt[5][2];
#pragma unroll
                for (int j = 0; j < 2; ++j) { bt[j][0] = *(const bf16x8*)(lds + bbase + (16 * SROW * j)); bt[j][1] = *(const bf16x8*)(lds + bbase + (16 * SROW * j + 64)); }
                bt[2][0] = bt[0][0]; bt[2][1] = bt[0][1]; bt[3][0] = bt[0][0]; bt[3][1] = bt[0][1]; bt[4][0] = bt[0][0]; bt[4][1] = bt[0][1];
                const int ar = abase - 2048;
                if (!(ABL & 2)) HY_K(2);
            }
#undef HY_K
        } else {
        const char* Rl = lds + FOFF + o * FB;
#pragma unroll 1
        for (int d1 = -D1MAX; d1 <= D1MAX; ++d1) {
#pragma unroll
            for (int kb = 0; kb < KB; ++kb) {
                bf16x8 af[MT], bfr[NT];
#pragma unroll
                for (int mt = 0; mt < MT; ++mt) { const int i0 = OFF - P * d1 - 16 * mt - n16 + 32 * kb + 8 * q4; const unsigned sh = (unsigned)(i0 & 1) * 16u;
                    const unsigned* rp = (const unsigned*)(Rl + (i0 >> 1) * 4);
                    const unsigned d0 = rp[0], dd1 = rp[1], d2 = rp[2], d3 = rp[3], d4 = rp[4];
                    u32x4 w; w.x = __builtin_amdgcn_alignbit(dd1, d0, sh); w.y = __builtin_amdgcn_alignbit(d2, dd1, sh); w.z = __builtin_amdgcn_alignbit(d3, d2, sh); w.w = __builtin_amdgcn_alignbit(d4, d3, sh);
                    af[mt] = __builtin_bit_cast(bf16x8, w); }
#pragma unroll
                for (int nt = 0; nt < NT; ++nt) { const int N = 16 * nt + n16, bl = N / NT1, t1 = N % NT1, s1 = t1 - d1; const bool ok = (unsigned)s1 < (unsigned)NT1;
                    u32x4 w = *(const u32x4*)(zw + (bl * NT1 + (ok ? s1 : 0)) * SROW + 64 * kb + 16 * q4);
                    if (!ok) w = (u32x4){0u, 0u, 0u, 0u};
                    bfr[nt] = __builtin_bit_cast(bf16x8, w); }
#pragma unroll
                for (int nt = 0; nt < NT; ++nt) {
#pragma unroll
                    for (int mt = 0; mt < MT; ++mt) acc[mt][nt] = __builtin_amdgcn_mfma_f32_16x16x32_bf16(af[mt], bfr[nt], acc[mt][nt], 0, 0, 0);
                }
            }
        }
        }
        const float skip = a.in[17][(l * 2 + o) * 512 + c];
        bf16* mp = (bf16*)(a.ws + WS_YT) + (size_t)c * MROWS + seq0;
        long to = n16 * P + 4 * q4;
        int zo = n16 * SROW + 8 * q4;
#pragma unroll
        for (int nt = 0; nt < NT; ++nt) {
#pragma unroll
            for (int mt = 0; mt < MT; ++mt) {
                char* zp = zw + zo + 32 * mt; const long t0 = to + 16 * mt;
                const u32x2 zv = *(const u32x2*)zp; const u32x2 gg = gt[mt][nt];
                const float y0 = bflo(gg.x) * (acc[mt][nt][0] + skip * bflo(zv.x)), y1 = bfhi(gg.x) * (acc[mt][nt][1] + skip * bfhi(zv.x));
                const float y2 = bflo(gg.y) * (acc[mt][nt][2] + skip * bflo(zv.y)), y3 = bfhi(gg.y) * (acc[mt][nt][3] + skip * bfhi(zv.y));
                if (o == 0) { u32x2 w; w.x = pk2(y0, y1); w.y = pk2(y2, y3); *(u32x2*)zp = w; }
                else if (ABL & 1) { if (y0 + y1 + y2 + y3 == 123.456f) mp[0] = 0; }
                else { u32x2 w; w.x = pk2(y0, y1); w.y = pk2(y2, y3); *(u32x2*)(mp + t0) = w; } }
            to += 16 * P; zo += 16 * SROW;
            asm volatile("" : "+v"(to), "+v"(zo)); }
    }
    __syncthreads();
}

namespace attn {
constexpr int D = 128, NW = 8, QBLK = 32, KVBLK = 64;
constexpr float SCALE = 0.088388347648318440f;
constexpr float THR = 8.f;
constexpr int LDQ = 4096, LDK = 128;
constexpr size_t SHM_V = KVBLK * D * 2, SHM_K = KVBLK * D * 2;
#define KSWZ(row, colB) ((row) * 256 + ((colB) ^ (((row) & 7) << 4)))
#define SBAR() __builtin_amdgcn_sched_barrier(0)
__device__ __forceinline__ int crow(int r, int hi) { return (r & 3) + 8 * (r >> 2) + 4 * hi; }
__device__ __forceinline__ unsigned cvtpk(float lo, float hi) { unsigned r; asm volatile("v_cvt_pk_bf16_f32 %0, %1, %2" : "=v"(r) : "v"(lo), "v"(hi)); return r; }
__device__ __forceinline__ void partialSM(f32x16& p0, f32x16& p1, float& m_reg, float& mn, float& alpha) {
  constexpr float C = SCALE * 1.4426950408889634f;
  float pmax = p0[0]; for (int r = 1; r < 16; ++r) pmax = fmaxf(pmax, p0[r]); for (int r = 0; r < 16; ++r) pmax = fmaxf(pmax, p1[r]);
  { auto rr = __builtin_amdgcn_permlane32_swap(__float_as_uint(pmax), __float_as_uint(pmax), false, false);
    pmax = fmaxf(__uint_as_float(rr[0]), __uint_as_float(rr[1])); }
  if (__builtin_expect(__all(pmax - m_reg <= THR / SCALE), 1)) { mn = m_reg; alpha = 1.f; }
  else { mn = fmaxf(m_reg, pmax); alpha = __builtin_amdgcn_exp2f((m_reg - mn) * C); m_reg = mn; }
  float mnC = -mn * C;
  for (int r = 0; r < 16; ++r) p0[r] = fmaf(p0[r], C, mnC); for (int r = 0; r < 16; ++r) p1[r] = fmaf(p1[r], C, mnC);
  for (int r = 0; r < 16; ++r) p0[r] = __builtin_amdgcn_exp2f(p0[r]);
}
__device__ __forceinline__ void finishSM(f32x16& p0, f32x16& p1, float alpha, float& l_reg, bf16x8& pa0, bf16x8& pa1, bf16x8& pa2, bf16x8& pa3) {
  for (int r = 0; r < 16; ++r) p1[r] = __builtin_amdgcn_exp2f(p1[r]);
  float ps = 0; for (int r = 0; r < 16; ++r) ps += p0[r]; for (int r = 0; r < 16; ++r) ps += p1[r];
  { auto rr = __builtin_amdgcn_permlane32_swap(__float_as_uint(ps), __float_as_uint(ps), false, false);
    ps = __uint_as_float(rr[0]) + __uint_as_float(rr[1]); }
  l_reg = l_reg * alpha + ps;
#define PK4(Pv, BASE, OUT) do { unsigned a0 = cvtpk(Pv[BASE + 0], Pv[BASE + 1]), a1 = cvtpk(Pv[BASE + 2], Pv[BASE + 3]);   \
    unsigned b0 = cvtpk(Pv[BASE + 4], Pv[BASE + 5]), b1 = cvtpk(Pv[BASE + 6], Pv[BASE + 7]);                              \
    auto r0 = __builtin_amdgcn_permlane32_swap(a0, b0, false, false); auto r1 = __builtin_amdgcn_permlane32_swap(a1, b1, false, false); \
    u32x4 w = {r0[0], r1[0], r0[1], r1[1]}; OUT = *reinterpret_cast<bf16x8*>(&w); } while (0)
  PK4(p0, 0, pa0); PK4(p0, 8, pa1); PK4(p1, 0, pa2); PK4(p1, 8, pa3);
#undef PK4
}
__device__ __forceinline__ void qkt(f32x16& p0, f32x16& p1, const bf16* Ks, const bf16x8* qr, int r32, int hi) {
  p0 = f32x16{}; p1 = f32x16{};
  for (int d0 = 0; d0 < 8; ++d0) { int cb = (d0 * 16 + hi * 8) * 2;
    bf16x8 b0 = *reinterpret_cast<const bf16x8*>((const char*)Ks + KSWZ(r32, cb));
    bf16x8 b1 = *reinterpret_cast<const bf16x8*>((const char*)Ks + KSWZ(32 + r32, cb));
    p0 = __builtin_amdgcn_mfma_f32_32x32x16_bf16(b0, qr[d0], p0, 0, 0, 0);
    p1 = __builtin_amdgcn_mfma_f32_32x32x16_bf16(b1, qr[d0], p1, 0, 0, 0); }
}
__device__ __forceinline__ int v_st(int k, int c) { const int kk = (k & ~0xC) | ((k & 4) << 1) | ((k & 8) >> 1); return ((kk >> 3) * 4 + (c >> 5)) * 512 + ((kk & 7) * 32 + (c & 31)) * 2; }
__device__ __forceinline__ int v_rd_base(int lane) { return ((lane & 3) << 3) | (((lane >> 2) & 3) << 6) | (((lane >> 4) & 1) << 5) | (((lane >> 5) & 1) << 8); }
constexpr int v_rd_off(int d0, int ks, int half) { return d0 * 512 + ks * 4096 + half * 2048; }
template <int OFFS> __device__ __forceinline__ s16x4 tr_read(int vb) {
  s16x4 r; asm volatile("ds_read_b64_tr_b16 %0, %1 offset:%2" : "=&v"(r) : "v"(vb), "i"(OFFS) : "memory"); return r;
}
template <int D0> __device__ __forceinline__ void pv_one(f32x16& od, int vb, bf16x8 pa0, bf16x8 pa1, bf16x8 pa2, bf16x8 pa3) {
  const s16x4 l0 = tr_read<v_rd_off(D0, 0, 0)>(vb), h0 = tr_read<v_rd_off(D0, 0, 1)>(vb), l1 = tr_read<v_rd_off(D0, 1, 0)>(vb), h1 = tr_read<v_rd_off(D0, 1, 1)>(vb);
  const s16x4 l2 = tr_read<v_rd_off(D0, 2, 0)>(vb), h2 = tr_read<v_rd_off(D0, 2, 1)>(vb), l3 = tr_read<v_rd_off(D0, 3, 0)>(vb), h3 = tr_read<v_rd_off(D0, 3, 1)>(vb);
  asm volatile("s_waitcnt lgkmcnt(0)" ::: "memory"); SBAR();
#define PK(Lx, Hx) (bf16x8){Lx[0], Lx[1], Lx[2], Lx[3], Hx[0], Hx[1], Hx[2], Hx[3]}
  od = __builtin_amdgcn_mfma_f32_32x32x16_bf16(pa0, PK(l0, h0), od, 0, 0, 0);
  od = __builtin_amdgcn_mfma_f32_32x32x16_bf16(pa1, PK(l1, h1), od, 0, 0, 0);
  od = __builtin_amdgcn_mfma_f32_32x32x16_bf16(pa2, PK(l2, h2), od, 0, 0, 0);
  od = __builtin_amdgcn_mfma_f32_32x32x16_bf16(pa3, PK(l3, h3), od, 0, 0, 0);
#undef PK
}
__device__ __forceinline__ void pv_d0(f32x16* o, int vb, bf16x8 pa0, bf16x8 pa1, bf16x8 pa2, bf16x8 pa3) {
  pv_one<0>(o[0], vb, pa0, pa1, pa2, pa3); pv_one<1>(o[1], vb, pa0, pa1, pa2, pa3); pv_one<2>(o[2], vb, pa0, pa1, pa2, pa3); pv_one<3>(o[3], vb, pa0, pa1, pa2, pa3);
}
__device__ __forceinline__ void attn_unit(const bf16* __restrict__ Qb, const bf16* __restrict__ Kh, const bf16* __restrict__ Vh,
                                          const bf16* __restrict__ Gb, bf16* __restrict__ Ob, int seq, char* lds, const int tid) {
  const int wid = tid >> 6, lane = tid & 63, r32 = lane & 31, hi = lane >> 5;
  bf16* V_lds = (bf16*)lds; bf16* K_lds = (bf16*)(lds + 2 * SHM_V);
  float* ws = (float*)(lds + 2 * SHM_V + 2 * SHM_K) + wid * 64; float* li_l = ws; float* al_l = ws + 32;
  float m_reg = -1e30f, l_reg = 0; f32x16 o[4] = {}; bf16x8 qr[8];
  const bf16* Qw = Qb + (long)(wid * QBLK + r32) * LDQ + hi * 8;
#pragma unroll
  for (int d0 = 0; d0 < 8; ++d0) qr[d0] = *reinterpret_cast<const bf16x8*>(Qw + d0 * 16);
  const int sr = tid >> 4, sc = (tid & 15) * 8, vst0 = v_st(sr, sc), vst1 = v_st(32 + sr, sc);
  const int vb0 = (int)(uintptr_t)V_lds + v_rd_base(lane);
  struct { bf16x8 vs0, vs1, ks0, ks1; } sr_[2];
#define SLOAD(i, k0) do { sr_[i].vs0 = *(const bf16x8*)(&Vh[(long)((k0) + sr) * LDK + sc]); sr_[i].vs1 = *(const bf16x8*)(&Vh[(long)((k0) + 32 + sr) * LDK + sc]); \
    sr_[i].ks0 = *(const bf16x8*)(&Kh[(long)((k0) + sr) * LDK + sc]); sr_[i].ks1 = *(const bf16x8*)(&Kh[(long)((k0) + 32 + sr) * LDK + sc]); } while (0)
#define SWRITE(b, i) do { *(bf16x8*)((char*)V_lds + (b) * SHM_V + vst0) = sr_[i].vs0;          \
    *(bf16x8*)((char*)V_lds + (b) * SHM_V + vst1) = sr_[i].vs1; int kc = sc * 2;               \
    *(bf16x8*)((char*)K_lds + (b) * SHM_K + KSWZ(sr, kc)) = sr_[i].ks0;                       \
    *(bf16x8*)((char*)K_lds + (b) * SHM_K + KSWZ(32 + sr, kc)) = sr_[i].ks1; } while (0)
#define SWAIT() asm volatile("s_waitcnt vmcnt(4)" ::: "memory")
#define RESC(av) do { if (__any((av) < 1.f)) { if (hi == 0) al_l[r32] = (av); asm volatile("s_waitcnt lgkmcnt(0)" ::: "memory"); \
    for (int d = 0; d < 4; ++d) for (int r = 0; r < 16; ++r) o[d][r] *= al_l[crow(r, hi)]; } } while (0)
  f32x16 pA0, pA1, pB0, pB1; float mnA, mnB, alA, alB; bf16x8 pa0, pa1, pa2, pa3; const int NT = seq / KVBLK;
  constexpr int SE = 0, SO = 1;
  SLOAD(SE, 0); asm volatile("s_waitcnt vmcnt(0)" ::: "memory"); SWRITE(0, SE); __syncthreads();
  qkt(pA0, pA1, K_lds, qr, r32, hi); partialSM(pA0, pA1, m_reg, mnA, alA);
  SLOAD(SO, KVBLK); if (2 < NT) SLOAD(SE, 2 * KVBLK);
  SWAIT(); SWRITE(1, SO); __syncthreads();
  for (int j = 1; j + 1 < NT; j += 2) {
    SBAR(); qkt(pB0, pB1, (bf16*)((char*)K_lds + SHM_K), qr, r32, hi);
    finishSM(pA0, pA1, alA, l_reg, pa0, pa1, pa2, pa3); SBAR();
    SLOAD(SO, (j + 2) * KVBLK); SBAR();
    pv_d0(o, vb0, pa0, pa1, pa2, pa3); partialSM(pB0, pB1, m_reg, mnB, alB);
    __syncthreads(); SWAIT(); SWRITE(0, SE);
    RESC(alB); __syncthreads();
    SBAR(); qkt(pA0, pA1, K_lds, qr, r32, hi);
    finishSM(pB0, pB1, alB, l_reg, pa0, pa1, pa2, pa3); SBAR();
    if (j + 3 < NT) SLOAD(SE, (j + 3) * KVBLK); SBAR();
    pv_d0(o, vb0 + (int)SHM_V, pa0, pa1, pa2, pa3); partialSM(pA0, pA1, m_reg, mnA, alA);
    __syncthreads(); SWAIT(); SWRITE(1, SO);
    RESC(alA); __syncthreads();
  }
  SBAR(); qkt(pB0, pB1, (bf16*)((char*)K_lds + SHM_K), qr, r32, hi);
  finishSM(pA0, pA1, alA, l_reg, pa0, pa1, pa2, pa3); SBAR();
  pv_d0(o, vb0, pa0, pa1, pa2, pa3); partialSM(pB0, pB1, m_reg, mnB, alB);
  __syncthreads(); RESC(alB);
  finishSM(pB0, pB1, alB, l_reg, pa0, pa1, pa2, pa3); SBAR();
  pv_d0(o, vb0 + (int)SHM_V, pa0, pa1, pa2, pa3);
  if (hi == 0) li_l[r32] = l_reg; asm volatile("s_waitcnt lgkmcnt(0)" ::: "memory"); SBAR();
  float rli[16];
#pragma unroll
  for (int r = 0; r < 16; ++r) rli[r] = __builtin_amdgcn_rcpf(li_l[crow(r, hi)]);
  long go = (long)(wid * QBLK + 4 * hi) * LDQ + r32, oo = (long)(wid * QBLK + 4 * hi) * 2048 + r32;
#pragma unroll
  for (int r = 0; r < 16; ++r) {
#pragma unroll
    for (int d0 = 0; d0 < 4; ++d0) { const float g = bf2f(Gb[go + d0 * 32]); Ob[oo + d0 * 32] = (bf16)f2bf(o[d0][r] * rli[r] * silu_f(g)); }
    const int step = ((r & 3) == 3) ? 5 : 1; go += step * LDQ; oo += step * 2048;
    asm volatile("" : "+v"(go), "+v"(oo) :: "memory"); }
  __syncthreads();
#undef SLOAD
#undef SWRITE
#undef SWAIT
#undef RESC
}
}

__device__ __forceinline__ void phase_ytr(const Args& a, char* lds, int tid, int G) {
    const bf16* YT = (const bf16*)(a.ws + WS_YT); bf16* MIX = (bf16*)(a.ws + WS_MIX);
    constexpr int TS = 144;
    for (int item = blockIdx.x; item < 576 * 2; item += G) {
        const int rt = item >> 1, ct = item & 1, r0 = rt * 64, c0 = ct * 256;
        __syncthreads();
        { const int ch = tid >> 3, part = tid & 7; u32x4 w[4];
#pragma unroll
          for (int i = 0; i < 4; ++i) w[i] = *(const u32x4*)(YT + (size_t)(c0 + ch + 64 * i) * MROWS + r0 + 8 * part);
#pragma unroll
          for (int i = 0; i < 4; ++i) *(u32x4*)(lds + (ch + 64 * i) * TS + ((part ^ ((ch >> 3) & 7)) * 16)) = w[i]; }
        __syncthreads();
#pragma unroll
        for (int i = 0; i < 4; ++i) { const int id = tid + 512 * i, r = id >> 5, cp = id & 31; unsigned short v[8];
#pragma unroll
          for (int j = 0; j < 8; ++j) v[j] = *(const unsigned short*)(lds + (8 * cp + j) * TS + ((((r >> 3) ^ (cp & 7)) * 16) + (r & 7) * 2));
          u32x4 w; w.x = v[0] | ((unsigned)v[1] << 16); w.y = v[2] | ((unsigned)v[3] << 16); w.z = v[4] | ((unsigned)v[5] << 16); w.w = v[6] | ((unsigned)v[7] << 16);
          *(u32x4*)(MIX + (size_t)(r0 + r) * 2048 + c0 + 8 * cp) = w; }
    }
    __syncthreads();
}

template <int SEL> __device__ __forceinline__ void phase_mix(const Args& a, int l, char* lds, int tid_in, int G) {
    const bf16* P = (const bf16*)(a.ws + WS_P); bf16* MIX = (bf16*)(a.ws + WS_MIX);
    const bf16* KL = (const bf16*)(a.ws + WS_KL); const bf16* VL = (const bf16*)(a.ws + WS_VL); const bf16* KP = (const bf16*)(a.ws + WS_KP); const bf16* VP = (const bf16*)(a.ws + WS_VP);
    constexpr int N_HS = 512, N_AS = 1024, N_HP = 512, N_PAD = 128, N_AP = 128, N_ALL = N_HS + N_AS + N_HP + N_PAD + N_AP;
    const int nround = (N_ALL + G - 1) / G; const bool swp = (SEL == 0xF) && (G == 256);
    for (int kr = 0; kr < nround; ++kr) {
        const int kk = (swp && kr < 4) ? ((kr + (int)(blockIdx.x & 3)) & 3) : kr; const int item = blockIdx.x + kk * G; if (item >= N_ALL) continue;
        int r = item;
        int tid = tid_in; asm volatile("" : "+v"(tid));
        const int lane = tid & 63, wave = __builtin_amdgcn_readfirstlane(tid >> 6);
#define HY_CH(r) ((((r) & 7) << 5) | (((r) >> 3) & 31) | ((r) & 256))
        if (r < N_HS) { if ((PMASK & 256) && (SEL & 1)) hyena_item<4096, 64, 1, (SEL == 1 ? HYABL : 0)>(a, l, HY_CH(r), lds, tid, lane, wave); continue; } r -= N_HS;
        if (r < N_AS + N_HP) {
            if (r >= N_AS) { if ((PMASK & 1024) && (SEL & 4)) hyena_item<256, 32, 2>(a, l, HY_CH(r - N_AS), lds, tid, lane, wave); continue; } }
        else { r -= N_HP; if (r < N_AS + N_PAD) continue; r -= N_PAD; }
        if ((PMASK & 512) && (r < N_AS ? (SEL & 2) : (SEL & 8))) {
            const bool lat = r < N_AS; const int rp = r - N_AS;
            const int h = lat ? (r >> 4) & 7 : (rp & 7), b = lat ? (r >> 7) : (rp >> 3), kvh = h >> 2;
            const size_t row0 = lat ? (size_t)MP + b * 4096 + (r & 15) * 256 : (size_t)b * 256;
            const int seq = lat ? SKV_S : LP;
            const bf16* Kb = (lat ? KL : KP) + (size_t)(b * 2 + kvh) * seq * 128; const bf16* Vb = (lat ? VL : VP) + (size_t)(b * 2 + kvh) * seq * 128;
            attn::attn_unit(P + row0 * PST + C_Q + h * 128, Kb, Vb, P + row0 * PST + C_ATG + h * 128, MIX + row0 * 2048 + 1024 + h * 128, seq, lds, tid);
        }
    }
    __syncthreads();
}


#define LAS __attribute__((address_space(3)))
#define XB_TMO      128
#define XB_XCNT(j)  (256  + 64 * (j))
#define XB_XSUB(j)  (1280 + 64 * (j))
#define XB_XGEN(j)  (2304 + 64 * (j))
#define XB_TOP      3328
#define XB_TOPGEN   3392
#define XCD_BAR_WORDS 3456
#define XB_SPIN_CAP (1u << 22)
__device__ __forceinline__ unsigned xb_ld(unsigned* p)              { return __hip_atomic_load(p, __ATOMIC_RELAXED, __HIP_MEMORY_SCOPE_AGENT); }
__device__ __forceinline__ unsigned xb_add(unsigned* p, unsigned v) { return __hip_atomic_fetch_add(p, v, __ATOMIC_RELAXED, __HIP_MEMORY_SCOPE_AGENT); }
__device__ __forceinline__ unsigned xb_xcc_id() { return (unsigned)__builtin_amdgcn_s_getreg((3 << 11) | 20) & 0xFu; }
#define XB_SPIN(cond, bar) do { unsigned _sp = 0; while (cond) { __builtin_amdgcn_s_sleep(1); \
    if ((++_sp & 255u) == 0u) { if (xb_ld(&(bar)[XB_TMO])) break; if (_sp > XB_SPIN_CAP) { atomicAdd(&(bar)[XB_TMO], 1u); break; } } } } while (0)
struct XcdBarrier { unsigned* bar; unsigned x; volatile LAS unsigned* st; };
__device__ __forceinline__ XcdBarrier xcd_barrier_post(unsigned* bar, volatile LAS unsigned* st) {
    XcdBarrier b; b.bar = bar; b.x = xb_xcc_id(); b.st = st;
    if (threadIdx.x == 0) (void)xb_add(&bar[XB_XCNT(b.x)], 1u);
    return b;
}
__device__ __forceinline__ void xcd_barrier_complete(unsigned* bar, unsigned x, unsigned& nloc, unsigned& nx) {
    const unsigned G = gridDim.x * gridDim.y * gridDim.z;
    unsigned sum, cnt, mine, sp = 0u;
    for (;;) {
        sum = 0u; cnt = 0u; mine = 0u;
#pragma unroll
        for (unsigned j = 0; j < 16; ++j) { const unsigned c = xb_ld(&bar[XB_XCNT(j)]); sum += c; cnt += (c > 0u) ? 1u : 0u; mine = (j == x) ? c : mine; }
        if (sum == G) break;
        __builtin_amdgcn_s_sleep(1);
        if ((++sp & 255u) == 0u) { if (xb_ld(&bar[XB_TMO])) break; if (sp > XB_SPIN_CAP) { atomicAdd(&bar[XB_TMO], 1u); break; } }
    }
    nloc = mine > 0u ? mine : 1u; nx = cnt > 0u ? cnt : 1u;
}
__device__ __forceinline__ void xcd_barrier(const XcdBarrier& b) {
    asm volatile("s_waitcnt vmcnt(0)" ::: "memory");
    __syncthreads();
    if (threadIdx.x == 0) {
        unsigned* bar = b.bar;
        __builtin_amdgcn_s_waitcnt(0);
        unsigned nloc = b.st[0], nx = b.st[1];
        if (nloc == 0u) { xcd_barrier_complete(bar, b.x, nloc, nx); b.st[0] = nloc; b.st[1] = nx; }
        const unsigned old = xb_add(&bar[XB_XSUB(b.x)], 1u);
        const unsigned gen = old / nloc;
        if (old + 1u == (gen + 1u) * nloc) {
            __builtin_amdgcn_fence(__ATOMIC_RELEASE, "agent");
            asm volatile("s_waitcnt vmcnt(0)" ::: "memory");
            const unsigned og = xb_add(&bar[XB_TOP], 1u);
            const unsigned tg = og / nx;
            if (og + 1u == (tg + 1u) * nx) xb_add(&bar[XB_TOPGEN], 1u);
            else XB_SPIN(xb_ld(&bar[XB_TOPGEN]) == tg, bar);
            __builtin_amdgcn_fence(__ATOMIC_ACQUIRE, "agent");
            xb_add(&bar[XB_XGEN(b.x)], 1u);
            asm volatile("s_waitcnt vmcnt(0)" ::: "memory");
        } else {
            XB_SPIN(xb_ld(&bar[XB_XGEN(b.x)]) == gen, bar);
            __builtin_amdgcn_fence(__ATOMIC_ACQUIRE, "agent");
            asm volatile("s_waitcnt vmcnt(0)" ::: "memory");
        }
    }
    __syncthreads();
}

constexpr int N_PHASES = 2 + 6 * NL;
__global__ void __launch_bounds__(512) fwd_megakernel(Args args_unused) {
    extern __shared__ __attribute__((aligned(16))) unsigned char lds_raw[];
    char* lds = (char*)lds_raw;
    const int G = gridDim.x;
    int lo, hi; unsigned* barw; { const Args a0 = load_args(); lo = a0.ph_lo; hi = a0.ph_hi; barw = (unsigned*)a0.ws; }
    volatile LAS unsigned* bst = (volatile LAS unsigned*)((LAS unsigned char*)lds_raw + (LDS_BYTES - 64));
    if (threadIdx.x < 16) bst[threadIdx.x] = 0u;
    __syncthreads();
    XcdBarrier xbar; xbar.bar = barw; xbar.x = 0; xbar.st = bst;
    if (hi - lo > 1) xbar = xcd_barrier_post(barw, bst);
    int ph = 0;
#define RUN(...) do { if (lo <= ph && ph < hi) { int tid = threadIdx.x; asm volatile("" : "+v"(tid)); const int lane = tid & 63, wave = __builtin_amdgcn_readfirstlane(tid >> 6); \
        const Args args = load_args(); (void)lane; (void)wave; __VA_ARGS__; \
        if (ph + 1 < hi) { if (hi == 0x7ffffff0) { asm volatile("s_waitcnt vmcnt(0)" ::: "memory"); __syncthreads(); cg::this_grid().sync(); } else xcd_barrier(xbar); } } ++ph; } while (0)
#define PM(b, ...) do { if (PMASK & (1 << b)) { __VA_ARGS__; } } while (0)
    RUN({ PM(0, phase0(args, lds, tid, lane, wave, G)); if (DUP & 16) { __syncthreads(); phase0(args, lds, tid, lane, wave, G); } });
    RUN({ PM(1, phase_filt2(args, lds, tid, G)); if (DUP & 16) phase_filt2(args, lds, tid, G); PM(2, phase_adaln(args, 0, lane, wave, G)); if (DUP & 64) { for (int i = 0; i < 40; ++i) xcd_barrier(xbar); } });
#pragma unroll 1
    for (int l = 0; l < NL; ++l) {
        RUN(PM(3, { pg8::Gemm g{(const bf16*)(args.ws + WS_H), (const bf16*)(args.ws + WS_WIN) + (size_t)l * 6144 * 2048, MROWS, DIN, DM};
              pg8::StaticOrder S; S.init(MROWS, DIN, G, (int)blockIdx.x);
              pg8::EpiIn E{(bf16*)(args.ws + WS_P), (bf16*)(args.ws + WS_ZT), MROWS};
              pg8::gemm_phase<pg8::EpiIn, pg8::StaticOrder, true, true>((PG8_LAS unsigned char*)lds_raw, g, S, E, tid);
              if (DUP & 1) pg8::gemm_phase<pg8::EpiIn, pg8::StaticOrder, true, true>((PG8_LAS unsigned char*)lds_raw, g, S, E, tid); }));
        RUN({ PM(5, prep_qkv(args, l, lane, wave, G)); });
        RUN({ PM(6, prep_chunkmlp(args, l, lds, tid, lane, wave, G)); if (DUP & 32) { prep_chunkmlp(args, l, lds, tid, lane, wave, G); }
              PM(7, phase_mix<0xF>(args, l, lds, tid, G)); if (DUP & 2) phase_mix<0x1>(args, l, lds, tid, G); if (DUP & 4) phase_mix<0x2>(args, l, lds, tid, G); if (DUP & 8) phase_mix<0xC>(args, l, lds, tid, G); });
        RUN({ phase_ytr(args, lds, tid, G); if (DUP & 1024) phase_ytr(args, lds, tid, G); });
        RUN(PM(3, { pg8::Gemm g{(const bf16*)(args.ws + WS_MIX), (const bf16*)(args.ws + WS_WOUT) + (size_t)l * 2048 * 2048, MROWS, DM, DM};
              pg8::StaticOrder S; S.init(MROWS, DM, G, (int)blockIdx.x);
              pg8::EpiResid E{l, ALPHA, 0};
              if (DUP & 256) { pg8::EpiResid E2{l, ALPHA, 1}; pg8::gemm_phase<pg8::EpiResid, pg8::StaticOrder, true, true>((PG8_LAS unsigned char*)lds_raw, g, S, E2, tid); }
              pg8::gemm_phase<pg8::EpiResid, pg8::StaticOrder, true, true>((PG8_LAS unsigned char*)lds_raw, g, S, E, tid); }));
        RUN({ PM(2, phase_adaln(args, l + 1, lane, wave, G)); if ((DUP & 128) && l + 1 < NL) phase_adaln(args, l + 1, lane, wave, G); });
    }
#undef RUN
}

extern "C" void kernel_launch(void* const* d_in, const int* in_sizes, int n_in, void* d_out, int out_size, void* d_ws, size_t ws_size, hipStream_t stream) {
    static int grid = 0;
    if (grid == 0) {
        if (n_in != 27 || ws_size < WS_END) { fprintf(stderr, "kernel_launch: unexpected n_in %d / ws_size %zu\n", n_in, ws_size); grid = -1; return; }
        int dev = 0, cus = 0, per_cu = 0;
        (void)hipGetDevice(&dev); (void)hipDeviceGetAttribute(&cus, hipDeviceAttributeMultiprocessorCount, dev);
        if (hipFuncSetAttribute((const void*)fwd_megakernel, hipFuncAttributeMaxDynamicSharedMemorySize, LDS_BYTES) != hipSuccess) { fprintf(stderr, "kernel_launch: hipFuncSetAttribute failed\n"); grid = -1; return; }
        if (hipOccupancyMaxActiveBlocksPerMultiprocessor(&per_cu, (const void*)fwd_megakernel, 512, LDS_BYTES) != hipSuccess || per_cu < 1) per_cu = 1;
        (void)hipGetLastError();
        grid = cus * 1;
        fprintf(stderr, "kernel_launch: cus %d per_cu %d grid %d\n", cus, per_cu, grid);
    }
    if (grid < 0) return;
    if (hipMemsetAsync(d_ws, 0, 16384, stream) != hipSuccess) { fprintf(stderr, "kernel_launch: memset failed\n"); return; }
    Args a{};
    for (int i = 0; i < 27; ++i) a.in[i] = (const float*)d_in[i];
    a.out = (float*)d_out; a.ws = (unsigned char*)d_ws;
#if MULTI_LAUNCH
    for (int p = 0; p < N_PHASES; ++p) { a.ph_lo = p; a.ph_hi = p + 1; hipLaunchKernelGGL(fwd_megakernel, dim3(grid), dim3(512), LDS_BYTES, stream, a); }
#else
    a.ph_lo = 0; a.ph_hi = N_PHASES;
    void* kargs[] = {&a};
    hipError_t e = hipLaunchCooperativeKernel((const void*)fwd_megakernel, dim3(grid), dim3(512), kargs, LDS_BYTES, stream);
    if (e != hipSuccess) fprintf(stderr, "cooperative launch failed: %s (grid %d)\n", hipGetErrorString(e), grid);
#endif
}
```
